# Optimizing an MI355X kernel written in HIP

```python
import jax, jax.numpy as jnp
from jax import lax
import numpy as np

D_MODEL = 2048
BATCH = 2
SEQ = 16384
DEPTH = 2

CONV_CH = D_MODEL // 2
CONV_WIDTH = 31
NSA_HEADS = 16
NSA_HEAD_DIM = 64
NSA_KV_GROUPS = 4
NSA_HPG = NSA_HEADS // NSA_KV_GROUPS
NSA_Q = NSA_HEADS * NSA_HEAD_DIM
NSA_KV = NSA_KV_GROUPS * NSA_HEAD_DIM
CMP_STRIDE = 16
CMP_BLOCK = 2 * CMP_STRIDE
CMP_HIDDEN = 256
SLC_BLOCK = 64
SLC_TOPK = 16
WINDOW = 512
Q_BLOCK = 128
FORCE_SCORE = 1.0e3
MIX_WIDTH = CONV_CH + NSA_Q
EVEN_SPLITS = (2 * CONV_CH, NSA_Q, NSA_KV, NSA_KV, NSA_KV, NSA_KV, NSA_KV, NSA_KV, 3 * NSA_HEADS)
EVEN_IN = 2 * CONV_CH + NSA_Q + 6 * NSA_KV + 3 * NSA_HEADS
HG_HEADS = 16
HG_DK = 128
HG_DV = D_MODEL // HG_HEADS
HG_CHUNK = 64
ODD_SPLITS = (HG_HEADS * HG_DK, HG_HEADS * HG_DK, HG_HEADS * HG_DV, HG_HEADS * HG_DV)
ODD_IN = 2 * HG_HEADS * HG_DK + 2 * HG_HEADS * HG_DV
FFN_HIDDEN = ((8 * D_MODEL // 3 + 255) // 256) * 256
N_EVEN = (DEPTH + 1) // 2
N_ODD = DEPTH // 2
EPS = 1e-6
TINY = 1e-30

kernel_name = "hybrid_conv_nsa_hgrn2_trunk"


def _split_cols(u, sizes):
    offs = np.cumsum(np.array(sizes))[:-1].tolist()
    return jnp.split(u, offs, axis=-1)


def rmsnorm(x, w):
    xf = x.astype(jnp.float32)
    y = xf * lax.rsqrt(jnp.mean(xf * xf, axis=-1, keepdims=True) + EPS)
    return (y * w.astype(jnp.float32)).astype(x.dtype)


def alibi_slopes(n_heads):
    return 2.0 ** (-8.0 * jnp.arange(1, n_heads + 1, dtype=jnp.float32) / n_heads)


def masked_softmax(s, mask):
    s = jnp.where(mask, s, -jnp.inf)
    m = jnp.max(s, axis=-1, keepdims=True)
    m = jnp.where(jnp.isfinite(m), m, 0.0)
    p = jnp.exp(s - m)
    return p / jnp.maximum(jnp.sum(p, axis=-1, keepdims=True), TINY)


def conformer_conv(u, conv_w, conv_b, ln_w, ln_b):
    a, g = jnp.split(u, 2, axis=-1)
    h = a * jax.nn.sigmoid(g)
    h = lax.conv_general_dilated(h, conv_w.astype(h.dtype), window_strides=(1,),
                                 padding=[(CONV_WIDTH - 1, 0)],
                                 dimension_numbers=('NWC', 'WIO', 'NWC'),
                                 feature_group_count=CONV_CH) + conv_b
    hf = h.astype(jnp.float32)
    mu = jnp.mean(hf, axis=-1, keepdims=True)
    var = jnp.mean(jnp.square(hf - mu), axis=-1, keepdims=True)
    hn = (hf - mu) * lax.rsqrt(var + EPS) * ln_w + ln_b
    return jax.nn.silu(hn).astype(u.dtype)


def compress_blocks(kv, pos, w1, b1, w2, b2):
    B, S, G, Dh = kv.shape
    halves = kv.reshape(B, S // CMP_STRIDE, CMP_STRIDE, G, Dh)
    blocks = jnp.concatenate([halves[:, :-1], halves[:, 1:]], axis=2)
    blocks = blocks + pos[None, None, :, None, :]
    flat = blocks.transpose(0, 1, 3, 2, 4).reshape(B, S // CMP_STRIDE - 1, G, CMP_BLOCK * Dh)
    return jax.nn.silu(flat @ w1 + b1) @ w2 + b2


def nsa_attention(q, k_cmp, v_cmp, k_slc, v_slc, k_win, v_win, gates):
    f32 = jnp.float32
    B, S = q.shape[:2]
    G, HPG, DH = NSA_KV_GROUPS, NSA_HPG, NSA_HEAD_DIM
    n_cmp = S // CMP_STRIDE - 1
    n_slc = S // SLC_BLOCK
    n_top = min(SLC_TOPK, n_slc)
    slopes = alibi_slopes(NSA_HEADS).reshape(G, HPG)
    q = q.astype(f32) * DH ** -0.5
    k_cmp = k_cmp.astype(f32)
    v_cmp = v_cmp.astype(f32)
    cmp_end = jnp.arange(n_cmp) * CMP_STRIDE + (CMP_BLOCK - 1)
    ci = jnp.arange(n_cmp)[:, None] * CMP_STRIDE
    sj = jnp.arange(n_slc)[None, :] * SLC_BLOCK
    overlap = ((ci < sj + SLC_BLOCK) & (ci + CMP_BLOCK > sj)).astype(f32)

    def to_blocks(t):
        return t.astype(f32).reshape(B, n_slc, SLC_BLOCK, G, DH).transpose(0, 3, 1, 2, 4).reshape(
            B, G, n_slc, SLC_BLOCK * DH)

    ks_blk, vs_blk = to_blocks(k_slc), to_blocks(v_slc)
    gather = jax.vmap(jax.vmap(lambda blk, ix: blk[ix]))
    pad = ((0, 0), (WINDOW, 0), (0, 0), (0, 0))
    kw_pad = jnp.pad(k_win.astype(f32), pad)
    vw_pad = jnp.pad(v_win.astype(f32), pad)
    nk = n_top * SLC_BLOCK

    def block(qb):
        t0 = qb * Q_BLOCK
        t = t0 + jnp.arange(Q_BLOCK)
        qblk = lax.dynamic_slice_in_dim(q, t0, Q_BLOCK, axis=1)
        gblk = lax.dynamic_slice_in_dim(gates, t0, Q_BLOCK, axis=1)
        dist = (t[:, None] - cmp_end[None, :]).astype(f32)
        s = jnp.einsum('bqghd,bngd->bghqn', qblk, k_cmp) - slopes[None, :, :, None, None] * dist
        p_cmp = masked_softmax(s, dist >= 0)
        o_cmp = jnp.einsum('bghqn,bngd->bqghd', p_cmp, v_cmp)
        imp = jnp.einsum('bgqn,nj->bgqj', jnp.sum(p_cmp, axis=2), overlap)
        cur = (t // SLC_BLOCK)[:, None]
        j = jnp.arange(n_slc)[None, :]
        forced = (j == 0) | (j == cur) | (j == cur - 1)
        imp = jnp.where(forced, FORCE_SCORE, jnp.where(j > cur, -1.0, imp))
        _, idx = lax.top_k(imp, n_top)
        flat_idx = idx.reshape(B, G, Q_BLOCK * n_top)
        k_sel = gather(ks_blk, flat_idx).reshape(B, G, Q_BLOCK, nk, DH)
        v_sel = gather(vs_blk, flat_idx).reshape(B, G, Q_BLOCK, nk, DH)
        pos = (idx[..., None] * SLC_BLOCK + jnp.arange(SLC_BLOCK)).reshape(B, G, Q_BLOCK, nk)
        dist = (t[None, None, :, None] - pos).astype(f32)
        s = jnp.einsum('bqghd,bgqmd->bghqm', qblk, k_sel) - slopes[None, :, :, None, None] * dist[:, :, None]
        p = masked_softmax(s, (dist >= 0)[:, :, None])
        o_slc = jnp.einsum('bghqm,bgqmd->bqghd', p, v_sel)
        kwin = lax.dynamic_slice_in_dim(kw_pad, t0, WINDOW + Q_BLOCK, axis=1)
        vwin = lax.dynamic_slice_in_dim(vw_pad, t0, WINDOW + Q_BLOCK, axis=1)
        kpos = t0 - WINDOW + jnp.arange(WINDOW + Q_BLOCK)
        dist = t[:, None] - kpos[None, :]
        mask = (dist >= 0) & (dist < WINDOW) & (kpos[None, :] >= 0)
        s = jnp.einsum('bqghd,bkgd->bghqk', qblk, kwin) - slopes[None, :, :, None, None] * dist.astype(f32)
        p = masked_softmax(s, mask)
        o_win = jnp.einsum('bghqk,bkgd->bqghd', p, vwin)
        o = (gblk[:, :, 0, :, :, None] * o_cmp + gblk[:, :, 1, :, :, None] * o_slc
             + gblk[:, :, 2, :, :, None] * o_win)
        return o.reshape(B, Q_BLOCK, NSA_Q)

    out = lax.map(block, jnp.arange(S // Q_BLOCK))
    return out.transpose(1, 0, 2, 3).reshape(B, S, NSA_Q)


def even_mixer(h, w_in, conv_w, conv_b, ln_w, ln_b, cmp_pos, cmp_w1, cmp_b1, cmp_w2, cmp_b2, w_out):
    B, S, _ = h.shape
    u = h @ w_in
    a_in, q, kc, vc, ks, vs, kw, vw, g = _split_cols(u, EVEN_SPLITS)
    a_out = conformer_conv(a_in, conv_w, conv_b, ln_w, ln_b)

    def kv(t):
        return t.reshape(B, S, NSA_KV_GROUPS, NSA_HEAD_DIM)

    k_cmp = compress_blocks(kv(kc), cmp_pos[0], cmp_w1[0], cmp_b1[0], cmp_w2[0], cmp_b2[0])
    v_cmp = compress_blocks(kv(vc), cmp_pos[1], cmp_w1[1], cmp_b1[1], cmp_w2[1], cmp_b2[1])
    gates = jax.nn.sigmoid(g.astype(jnp.float32)).reshape(B, S, 3, NSA_KV_GROUPS, NSA_HPG)
    b_out = nsa_attention(q.reshape(B, S, NSA_KV_GROUPS, NSA_HPG, NSA_HEAD_DIM), k_cmp, v_cmp,
                          kv(ks), kv(vs), kv(kw), kv(vw), gates).astype(h.dtype)
    return jnp.concatenate([a_out, b_out], axis=-1) @ w_out


def odd_mixer(h, w_in, lb, gnorm_w, w_out):
    f32 = jnp.float32
    B, S, _ = h.shape
    q, f_logit, i, g = _split_cols(h @ w_in, ODD_SPLITS)
    f = lb + (1.0 - lb) * jax.nn.sigmoid(f_logit.astype(f32))
    log_f = jnp.log(jnp.maximum(f, TINY))
    k = 1.0 - f
    n_chunk = S // HG_CHUNK

    def chunks(t, d):
        return t.astype(f32).reshape(B, n_chunk, HG_CHUNK, HG_HEADS, d).transpose(1, 0, 3, 2, 4)

    xs = (chunks(q, HG_DK), chunks(k, HG_DK), chunks(log_f, HG_DK), chunks(i, HG_DV))
    causal = jnp.tril(jnp.ones((HG_CHUNK, HG_CHUNK), dtype=bool))[:, :, None]

    def step(state, inp):
        qc, kc, gc, ic = inp
        Gc = jnp.cumsum(gc, axis=2)
        o_inter = jnp.einsum('bhtk,bhkv->bhtv', qc * jnp.exp(Gc), state)
        decay = jnp.exp(jnp.where(causal, Gc[:, :, :, None, :] - Gc[:, :, None, :, :], -jnp.inf))
        a = jnp.einsum('bhtk,bhsk,bhtsk->bhts', qc, kc, decay)
        o_intra = jnp.einsum('bhts,bhsv->bhtv', a, ic)
        g_last = Gc[:, :, -1, :]
        state = (jnp.exp(g_last)[..., None] * state
                 + jnp.einsum('bhsk,bhsv->bhkv', kc * jnp.exp(g_last[:, :, None, :] - Gc), ic))
        return state, o_inter + o_intra

    s0 = jnp.zeros((B, HG_HEADS, HG_DK, HG_DV), f32)
    _, o = lax.scan(step, s0, xs)
    o = o.transpose(1, 0, 3, 2, 4).reshape(B, S, HG_HEADS, HG_DV)
    o = o * lax.rsqrt(jnp.mean(o * o, axis=-1, keepdims=True) + EPS) * gnorm_w.astype(f32).reshape(HG_HEADS, HG_DV)
    o = (o.reshape(B, S, HG_HEADS * HG_DV) * jax.nn.silu(g.astype(f32))).astype(h.dtype)
    return o @ w_out


def swiglu(h, w_gu, w_down):
    a, b = jnp.split(h @ w_gu, 2, axis=-1)
    return (jax.nn.silu(a) * b) @ w_down


def setup_inputs(seed: int = 0) -> dict:
    key = jax.random.key(seed)
    ks = jax.random.split(key, 20)
    dh = NSA_HEAD_DIM

    def nrm(k, shape, scale):
        return jax.random.normal(k, shape, jnp.float32) * scale

    return {
        "x": nrm(ks[0], (BATCH, SEQ, D_MODEL), 1.0),
        "norm_w": 1.0 + nrm(ks[1], (DEPTH, 2, D_MODEL), 0.02),
        "final_norm_w": 1.0 + nrm(ks[2], (D_MODEL,), 0.02),
        "ev_w_in": nrm(ks[3], (N_EVEN, D_MODEL, EVEN_IN), D_MODEL ** -0.5),
        "ev_conv_w": nrm(ks[4], (N_EVEN, CONV_WIDTH, 1, CONV_CH), CONV_WIDTH ** -0.5),
        "ev_conv_b": nrm(ks[5], (N_EVEN, CONV_CH), 0.02),
        "ev_conv_ln_w": 1.0 + nrm(ks[6], (N_EVEN, CONV_CH), 0.02),
        "ev_conv_ln_b": nrm(ks[7], (N_EVEN, CONV_CH), 0.02),
        "ev_cmp_pos": nrm(ks[8], (N_EVEN, 2, CMP_BLOCK, dh), 0.1),
        "ev_cmp_w1": nrm(ks[9], (N_EVEN, 2, CMP_BLOCK * dh, CMP_HIDDEN), (CMP_BLOCK * dh) ** -0.5),
        "ev_cmp_b1": nrm(ks[10], (N_EVEN, 2, CMP_HIDDEN), 0.02),
        "ev_cmp_w2": nrm(ks[11], (N_EVEN, 2, CMP_HIDDEN, dh), CMP_HIDDEN ** -0.5),
        "ev_cmp_b2": nrm(ks[12], (N_EVEN, 2, dh), 0.02),
        "ev_w_out": nrm(ks[13], (N_EVEN, MIX_WIDTH, D_MODEL), MIX_WIDTH ** -0.5),
        "od_w_in": nrm(ks[14], (N_ODD, D_MODEL, ODD_IN), D_MODEL ** -0.5),
        "od_lb_gamma": nrm(ks[15], (DEPTH, HG_HEADS * HG_DK), 0.5),
        "od_gnorm_w": 1.0 + nrm(ks[16], (N_ODD, HG_HEADS * HG_DV), 0.02),
        "od_w_out": nrm(ks[17], (N_ODD, HG_HEADS * HG_DV, D_MODEL), (HG_HEADS * HG_DV) ** -0.5),
        "ffn_w_gu": nrm(ks[18], (DEPTH, D_MODEL, 2 * FFN_HIDDEN), D_MODEL ** -0.5),
        "ffn_w_down": nrm(ks[19], (DEPTH, FFN_HIDDEN, D_MODEL), FFN_HIDDEN ** -0.5),
    }


def reference(x, norm_w, final_norm_w, ev_w_in, ev_conv_w, ev_conv_b, ev_conv_ln_w, ev_conv_ln_b,
              ev_cmp_pos, ev_cmp_w1, ev_cmp_b1, ev_cmp_w2, ev_cmp_b2, ev_w_out,
              od_w_in, od_lb_gamma, od_gnorm_w, od_w_out, ffn_w_gu, ffn_w_down):
    lb_all = jnp.cumsum(jax.nn.softmax(od_lb_gamma.astype(jnp.float32), axis=0), axis=0)
    lb_all = lb_all - lb_all[0]
    for layer in range(DEPTH):
        h = rmsnorm(x, norm_w[layer, 0])
        if layer % 2 == 0:
            e = layer // 2
            x = x + even_mixer(h, ev_w_in[e], ev_conv_w[e], ev_conv_b[e], ev_conv_ln_w[e], ev_conv_ln_b[e],
                               ev_cmp_pos[e], ev_cmp_w1[e], ev_cmp_b1[e], ev_cmp_w2[e], ev_cmp_b2[e], ev_w_out[e])
        else:
            o = layer // 2
            x = x + odd_mixer(h, od_w_in[o], lb_all[layer], od_gnorm_w[o], od_w_out[o])
        h = rmsnorm(x, norm_w[layer, 1])
        x = x + swiglu(h, ffn_w_gu[layer], ffn_w_down[layer])
    return rmsnorm(x, final_norm_w)
```

```cpp
#include <hip/hip_runtime.h>
#include <hip/hip_cooperative_groups.h>
#include <cstdio>
#include <cstdint>
namespace cg = cooperative_groups;
namespace pg8 {
#define PG8_LAS __attribute__((address_space(3)))
typedef unsigned short bf16_t;
typedef short bf16x8 __attribute__((ext_vector_type(8)));
typedef float f32x4 __attribute__((ext_vector_type(4)));
typedef unsigned u32x4 __attribute__((ext_vector_type(4)));
constexpr int BM = 256, BK = 64, HALF = 128, HTB = HALF * BK * 2  , STAGE_BYTES = 8 * HTB, NXCD = 8, WGM = 4;

__host__ __device__ __forceinline__ int lds_byte(int r, int c) { const int st = (r >> 4) * 2 + (c >> 5), rr = r & 15, cc = c & 31, ob = rr * 64 + cc * 2; return st * 1024 + (ob ^ (((ob >> 9) & 1) << 5)); }
__host__ __device__ __forceinline__ void stage_rc(int b, int& R, int& C) { const int st = b / 1024, sb = b % 1024, swz = sb ^ (((sb >> 9) & 1) << 5); R = (st >> 1) * 16 + swz / 64; C = (st & 1) * 32 + (swz % 64) / 2; }
__host__ __device__ __forceinline__ int perm32(int rho) { const int n = rho >> 4, i = rho & 15; return 8 * (i >> 2) + 4 * n + (i & 3); }

struct Unit { int pm, pn; };
struct Gemm { const bf16_t* A; const bf16_t* Bt; int M, N, K; };

struct StaticOrder {
    int nM, nN, nwg, G, c;
    __host__ __device__ void init(int M, int N, int G_, int c_) { nM = M / BM; nN = N / BM; nwg = nM * nN; G = G_; c = c_; }
    __host__ __device__ bool next(int i, Unit& u) const {
        const long L = (long)i * G + c; if (L >= nwg) return false;
        int wgid = (int)L; { const int q = nwg / NXCD, r = nwg % NXCD, xcd = wgid % NXCD, off = wgid / NXCD; wgid = (xcd < r ? xcd * (q + 1) : r * (q + 1) + (xcd - r) * q) + off; }
        const int nig = WGM * nN, gid = wgid / nig, fm = gid * WGM, gsz = (nM - fm) < WGM ? (nM - fm) : WGM;
        u.pm = fm + ((wgid % nig) % gsz); u.pn = (wgid % nig) / gsz; return true;
    }
    __device__ __forceinline__ void a_ready(const Unit&) const {}
    __device__ __forceinline__ void done(const Unit&) const {}
};

__device__ __forceinline__ unsigned cvt_pk_bf16(float lo, float hi) { unsigned r; asm volatile("v_cvt_pk_bf16_f32 %0, %1, %2" : "=v"(r) : "v"(lo), "v"(hi)); return r; }
__device__ __forceinline__ float sigmoidf_(float x) { return __builtin_amdgcn_rcpf(1.0f + __expf(-x)); }
struct EpiStore {
    static constexpr bool PERM = true, AFTER_DRAIN = false;
    bf16_t* O; int ldc; int pn0;
    __device__ __forceinline__ void operator()(const f32x4 (&acc)[2][2][4][2], const Unit& u, int wr, int wc, int fr, int fq) const {
        const int row0 = u.pm * BM + wr * 64 + fr; const int col0 = (u.pn - pn0) * BM + wc * 32 + 8 * fq;
#pragma unroll
        for (int ai = 0; ai < 2; ++ai)
#pragma unroll
            for (int m = 0; m < 4; ++m) { bf16_t* rowp = O + (size_t)(row0 + ai * HALF + m * 16) * ldc + col0;
#pragma unroll
                for (int bj = 0; bj < 2; ++bj) { const f32x4 v0 = acc[ai][bj][m][0], v1 = acc[ai][bj][m][1];
                    u32x4 w; w.x = cvt_pk_bf16(v0[0], v0[1]); w.y = cvt_pk_bf16(v0[2], v0[3]); w.z = cvt_pk_bf16(v1[0], v1[1]); w.w = cvt_pk_bf16(v1[2], v1[3]);
                    *(u32x4*)(rowp + bj * HALF) = w; } }
    }
};
template <int MODE> __device__ __forceinline__ void gated_store(const f32x4 (&acc)[2][2][4][2], const Unit& u, int wr, int wc, int fr, int fq, bf16_t* G, int ldg) {
    const int row0 = u.pm * BM + wr * 64 + fr; const int col0 = u.pn * HALF + wc * 32 + 8 * fq;
#pragma unroll
    for (int ai = 0; ai < 2; ++ai)
#pragma unroll
        for (int m = 0; m < 4; ++m) { bf16_t* rowp = G + (size_t)(row0 + ai * HALF + m * 16) * ldg + col0;
            float o[8];
#pragma unroll
            for (int n = 0; n < 2; ++n)
#pragma unroll
                for (int e = 0; e < 4; ++e) { const float a = acc[ai][0][m][n][e], b = acc[ai][1][m][n][e];
                    o[n * 4 + e] = (MODE == 0) ? a * sigmoidf_(b) : a * sigmoidf_(a) * b; }
            u32x4 w; w.x = cvt_pk_bf16(o[0], o[1]); w.y = cvt_pk_bf16(o[2], o[3]); w.z = cvt_pk_bf16(o[4], o[5]); w.w = cvt_pk_bf16(o[6], o[7]);
            *(u32x4*)rowp = w; }
}
struct EpiSwiglu {
    static constexpr bool PERM = true, AFTER_DRAIN = false;
    bf16_t* G; int ldg;
    __device__ __forceinline__ void operator()(const f32x4 (&acc)[2][2][4][2], const Unit& u, int wr, int wc, int fr, int fq) const { gated_store<1>(acc, u, wr, wc, fr, fq, G, ldg); }
};
struct EpiEvenIn {
    static constexpr bool PERM = true, AFTER_DRAIN = false;
    bf16_t* HG; bf16_t* U2; int ldu;
    __device__ __forceinline__ void operator()(const f32x4 (&acc)[2][2][4][2], const Unit& u, int wr, int wc, int fr, int fq) const {
        if (u.pn < 8) gated_store<0>(acc, u, wr, wc, fr, fq, HG, 1024);
        else { EpiStore E{U2, ldu, 8}; E(acc, u, wr, wc, fr, fq); }
    }
};
struct EpiResid {
    static constexpr bool PERM = false, AFTER_DRAIN = false;
    const float* base; float* out; int ldc;
    __device__ __forceinline__ void operator()(const f32x4 (&acc)[2][2][4][2], const Unit& u, int wr, int wc, int fr, int fq) const {
        const int col0 = u.pn * BM + wc * 32 + 4 * fq;
#pragma unroll
        for (int ai = 0; ai < 2; ++ai)
#pragma unroll
            for (int m = 0; m < 4; ++m) { const size_t off = (size_t)(u.pm * BM + ai * HALF + wr * 64 + m * 16 + fr) * ldc + col0;
#pragma unroll
                for (int bj = 0; bj < 2; ++bj)
#pragma unroll
                    for (int n = 0; n < 2; ++n) { const f32x4 bs = *(const f32x4*)(base + off + bj * HALF + n * 16); *(f32x4*)(out + off + bj * HALF + n * 16) = bs + acc[ai][bj][m][n]; } }
    }
};
struct EpiCmpHid {
    static constexpr bool PERM = true, AFTER_DRAIN = false;
    bf16_t* O; const float* bias;
    __device__ __forceinline__ void operator()(const f32x4 (&acc)[2][2][4][2], const Unit& u, int wr, int wc, int fr, int fq) const {
        const int row0 = u.pm * BM + wr * 64 + fr; const int col0 = wc * 32 + 8 * fq; const float* bb = bias + u.pn * 256;
#pragma unroll
        for (int ai = 0; ai < 2; ++ai)
#pragma unroll
            for (int m = 0; m < 4; ++m) { bf16_t* rowp = O + (size_t)(row0 + ai * HALF + m * 16) * 256 + col0;
#pragma unroll
                for (int bj = 0; bj < 2; ++bj) { float o[8];
#pragma unroll
                    for (int n = 0; n < 2; ++n)
#pragma unroll
                        for (int e = 0; e < 4; ++e) { const float v = acc[ai][bj][m][n][e] + bb[col0 + bj * HALF + n * 4 + e]; o[n * 4 + e] = v * sigmoidf_(v); }
                    u32x4 w; w.x = cvt_pk_bf16(o[0], o[1]); w.y = cvt_pk_bf16(o[2], o[3]); w.z = cvt_pk_bf16(o[4], o[5]); w.w = cvt_pk_bf16(o[6], o[7]);
                    *(u32x4*)(rowp + bj * HALF) = w; } }
    }
};
struct CmpOrder {
    int G, c;
    __device__ bool next(int i, Unit& u) const { const int L = i * G + c; if (L >= 64) return false; u.pm = L; u.pn = L >> 5; return true; }
    __device__ __forceinline__ void a_ready(const Unit&) const {}
    __device__ __forceinline__ void done(const Unit&) const {}
};
template <class Epi, class Sched, bool ALIGN_EPI = false, bool SP2 = false>
__device__ __forceinline__ void gemm_phase(PG8_LAS unsigned char* lds, const Gemm g, const Sched& S, const Epi& E) {
    const int tid = threadIdx.x, wid = __builtin_amdgcn_readfirstlane(tid >> 6), lane = tid & 63, wr = wid >> 2, wc = wid & 3, fr = lane & 15, fq = lane >> 4;
    const int K = g.K, nt = K / BK;
    unsigned voffA[2], voffB[2];
#pragma unroll
    for (int i = 0; i < 2; ++i) { int R, C; stage_rc(tid * 16 + i * 8192, R, C); const int Rb = Epi::PERM ? ((R & ~31) + perm32(R & 31)) : R;
        voffA[i] = (unsigned)(R * K + C) * 2u; voffB[i] = (unsigned)(Rb * K + C) * 2u; }
    const size_t kstep = (size_t)(BK * 2);
    const size_t hstep = (size_t)HALF * K * 2;
    const size_t tstep = 2 * hstep;
    const unsigned ldsw = (unsigned)wid * 1024u;
    const int aoff = lds_byte(wr * 64 + fr, fq * 8), boff = lds_byte(wc * 32 + fr, fq * 8);
#define PG8_SA(b, h) (((b) * 2 + (h)) * HTB)
#define PG8_SB(b, h) ((4 + (b) * 2 + (h)) * HTB)
#define PG8_STAGE(bufoff, gbase, voff) do { _Pragma("unroll") for (int _i = 0; _i < 2; ++_i) \
        __builtin_amdgcn_global_load_lds((const unsigned*)((const char*)(gbase) + (voff)[_i]), (PG8_LAS unsigned*)(lds + (bufoff) + ldsw + _i * 8192), 16, 0, 0); } while (0)
#define PG8_LDA(dst, b, h) do { _Pragma("unroll") for (int m = 0; m < 4; ++m) _Pragma("unroll") for (int k = 0; k < 2; ++k) dst[m][k] = *(const PG8_LAS bf16x8*)(lds + PG8_SA(b, h) + aoff + m * 2048 + k * 1024); } while (0)
#define PG8_LDB(dst, b, h) do { _Pragma("unroll") for (int n = 0; n < 2; ++n) _Pragma("unroll") for (int k = 0; k < 2; ++k) dst[n][k] = *(const PG8_LAS bf16x8*)(lds + PG8_SB(b, h) + boff + n * 2048 + k * 1024); } while (0)
#define PG8_MMA(ai, bj, At, Bt) do { __builtin_amdgcn_s_setprio(1); _Pragma("unroll") for (int m = 0; m < 4; ++m) _Pragma("unroll") for (int n = 0; n < 2; ++n) _Pragma("unroll") for (int k = 0; k < 2; ++k) \
        acc[ai][bj][m][n] = __builtin_amdgcn_mfma_f32_16x16x32_bf16(Bt[n][k], At[m][k], acc[ai][bj][m][n], 0, 0, 0); __builtin_amdgcn_s_setprio(0); } while (0)
#define PG8_WAIT_V(n) asm volatile("s_waitcnt vmcnt(" #n ")" ::: "memory")
#define PG8_WAIT_L(n) asm volatile("s_waitcnt lgkmcnt(" #n ")" ::: "memory")
#define PG8_BAR __builtin_amdgcn_s_barrier()
#define PG8_SCHED __builtin_amdgcn_sched_barrier(0)
    Unit cur, nxt; int ui = 0;
    if (!S.next(0, cur)) return;
    f32x4 acc[2][2][4][2];
#pragma unroll
    for (int a = 0; a < 2; ++a)
#pragma unroll
        for (int b = 0; b < 2; ++b)
#pragma unroll
            for (int m = 0; m < 4; ++m)
#pragma unroll
                for (int n = 0; n < 2; ++n) acc[a][b][m][n] = (f32x4){0.f, 0.f, 0.f, 0.f};
    bf16x8 At[4][2], B0[2][2], B1[2][2];
    const char* cA = (const char*)g.A + (size_t)cur.pm * tstep; const char* cB = (const char*)g.Bt + (size_t)cur.pn * tstep;
    S.a_ready(cur);
    if constexpr (SP2) {
        PG8_STAGE(PG8_SB(0, 0), cB, voffB); PG8_STAGE(PG8_SB(0, 1), cB + hstep, voffB); PG8_STAGE(PG8_SA(0, 0), cA, voffA); PG8_STAGE(PG8_SA(0, 1), cA + hstep, voffA);
        if (wr == 1) PG8_BAR;
        PG8_WAIT_V(2); PG8_BAR;
        PG8_STAGE(PG8_SB(1, 0), cB + kstep, voffB); PG8_STAGE(PG8_SA(1, 0), cA + kstep, voffA); PG8_STAGE(PG8_SB(1, 1), cB + hstep + kstep, voffB);
        PG8_WAIT_V(6); PG8_BAR;
    } else {
        PG8_STAGE(PG8_SB(0, 0), cB, voffB); PG8_STAGE(PG8_SA(0, 0), cA, voffA); PG8_STAGE(PG8_SB(0, 1), cB + hstep, voffB); PG8_STAGE(PG8_SA(0, 1), cA + hstep, voffA);
        if (wr == 1) PG8_BAR;
        PG8_WAIT_V(4); PG8_BAR;
        PG8_STAGE(PG8_SB(1, 0), cB + kstep, voffB); PG8_STAGE(PG8_SA(1, 0), cA + kstep, voffA); PG8_STAGE(PG8_SB(1, 1), cB + hstep + kstep, voffB);
        PG8_WAIT_V(6); PG8_BAR;
    }
    for (;;) {
        const bool has_next = S.next(ui + 1, nxt);
        const char* nA = has_next ? (const char*)g.A + (size_t)nxt.pm * tstep : cA; const char* nB = has_next ? (const char*)g.Bt + (size_t)nxt.pn * tstep : cB;
        for (int t = 0; t < nt; t += 2) {
            const bool last = (t == nt - 2);
            const char* a1 = cA + (size_t)(t + 1) * kstep;
            const char* a2 = last ? nA : cA + (size_t)(t + 2) * kstep; const char* b2 = last ? nB : cB + (size_t)(t + 2) * kstep;
            const char* a3 = a2 + kstep; const char* b3 = b2 + kstep;
            if (last && has_next) S.a_ready(nxt);
            if constexpr (SP2) {
            PG8_LDB(B0, 0, 0); PG8_LDB(B1, 0, 1); PG8_SCHED; PG8_LDA(At, 0, 0); PG8_STAGE(PG8_SA(1, 1), a1 + hstep, voffA);
            PG8_WAIT_V(8); PG8_WAIT_L(0); PG8_BAR; PG8_MMA(0, 0, At, B0); PG8_MMA(0, 1, At, B1); PG8_BAR; PG8_SCHED;
            PG8_LDA(At, 0, 1); PG8_STAGE(PG8_SB(0, 0), b2, voffB); PG8_STAGE(PG8_SB(0, 1), b2 + hstep, voffB); PG8_STAGE(PG8_SA(0, 0), a2, voffA);
            PG8_WAIT_V(8); PG8_WAIT_L(0); PG8_BAR; PG8_MMA(1, 0, At, B0); PG8_MMA(1, 1, At, B1); PG8_BAR; PG8_SCHED;
            PG8_LDB(B0, 1, 0); PG8_LDB(B1, 1, 1); PG8_SCHED; PG8_LDA(At, 1, 0); PG8_STAGE(PG8_SA(0, 1), a2 + hstep, voffA);
            PG8_WAIT_V(8); PG8_WAIT_L(0); PG8_BAR; PG8_MMA(0, 0, At, B0); PG8_MMA(0, 1, At, B1); PG8_BAR; PG8_SCHED;
            PG8_LDA(At, 1, 1); PG8_STAGE(PG8_SB(1, 0), b3, voffB); PG8_STAGE(PG8_SB(1, 1), b3 + hstep, voffB); PG8_STAGE(PG8_SA(1, 0), a3, voffA);
            PG8_WAIT_V(8); PG8_WAIT_L(0); PG8_BAR; PG8_MMA(1, 0, At, B0); PG8_MMA(1, 1, At, B1); PG8_BAR; PG8_SCHED;
            } else {
            PG8_LDB(B0, 0, 0); PG8_SCHED; PG8_LDA(At, 0, 0); PG8_STAGE(PG8_SA(1, 1), a1 + hstep, voffA);
            PG8_WAIT_L(8); PG8_BAR; PG8_WAIT_L(0); PG8_MMA(0, 0, At, B0); PG8_BAR; PG8_SCHED;
            PG8_LDB(B1, 0, 1); PG8_STAGE(PG8_SB(0, 0), b2, voffB);
            PG8_BAR; PG8_WAIT_L(0); PG8_MMA(0, 1, At, B1); PG8_BAR;
            PG8_LDA(At, 0, 1); PG8_STAGE(PG8_SA(0, 0), a2, voffA);
            PG8_BAR; PG8_WAIT_L(0); PG8_MMA(1, 0, At, B0); PG8_BAR; PG8_SCHED;
            PG8_STAGE(PG8_SB(0, 1), b2 + hstep, voffB);
            PG8_WAIT_V(6); PG8_BAR; PG8_MMA(1, 1, At, B1); PG8_BAR;
            PG8_LDB(B0, 1, 0); PG8_SCHED; PG8_LDA(At, 1, 0); PG8_STAGE(PG8_SA(0, 1), a2 + hstep, voffA);
            PG8_WAIT_L(8); PG8_BAR; PG8_WAIT_L(0); PG8_MMA(0, 0, At, B0); PG8_BAR; PG8_SCHED;
            PG8_LDB(B1, 1, 1); PG8_STAGE(PG8_SB(1, 0), b3, voffB);
            PG8_BAR; PG8_WAIT_L(0); PG8_MMA(0, 1, At, B1); PG8_BAR;
            PG8_LDA(At, 1, 1); PG8_STAGE(PG8_SA(1, 0), a3, voffA);
            PG8_BAR; PG8_WAIT_L(0); PG8_MMA(1, 0, At, B0); PG8_BAR; PG8_SCHED;
            PG8_STAGE(PG8_SB(1, 1), b3 + hstep, voffB);
            PG8_WAIT_V(6); PG8_BAR; PG8_MMA(1, 1, At, B1); PG8_BAR;
            }
        }
        if constexpr (ALIGN_EPI) { if (wr == 0) PG8_BAR; }
        if constexpr (!Epi::AFTER_DRAIN) { E(acc, cur, wr, wc, fr, fq); S.done(cur); }
        if (!has_next) break;
#pragma unroll
        for (int a = 0; a < 2; ++a)
#pragma unroll
            for (int b = 0; b < 2; ++b)
#pragma unroll
                for (int m = 0; m < 4; ++m)
#pragma unroll
                    for (int n = 0; n < 2; ++n) acc[a][b][m][n] = (f32x4){0.f, 0.f, 0.f, 0.f};
        cur = nxt; cA = nA; cB = nB; ++ui;
        if constexpr (ALIGN_EPI) { if (wr == 1) PG8_BAR; }
    }
    PG8_WAIT_V(0);
    if constexpr (!ALIGN_EPI) { if (wr == 0) PG8_BAR; }
    PG8_BAR;
    if constexpr (Epi::AFTER_DRAIN) { E.fused(acc, cur, wr, wc, fr, fq, lds, wid, lane); S.done(cur); }
#undef PG8_SA
#undef PG8_SB
#undef PG8_STAGE
#undef PG8_LDA
#undef PG8_LDB
#undef PG8_MMA
#undef PG8_WAIT_V
#undef PG8_WAIT_L
#undef PG8_BAR
#undef PG8_SCHED
}
}

#define LAS __attribute__((address_space(3)))
typedef unsigned short bf16;
typedef float f32x4 __attribute__((ext_vector_type(4)));
typedef short bf16x8 __attribute__((ext_vector_type(8)));
typedef unsigned v4u __attribute__((ext_vector_type(4)));
typedef unsigned v2u __attribute__((ext_vector_type(2)));
typedef unsigned long long u64;
typedef float f32x2 __attribute__((ext_vector_type(2)));
constexpr int NB = 2, SEQ = 16384, T = NB * SEQ, DM = 2048, FF = 5632;
constexpr int EV_REAL = 4656, EV_N = 4864, U2_LD = 2816;
constexpr int U2_Q = 0, U2_KC = 1024, U2_VC = 1280, U2_KS = 1536, U2_VS = 1792, U2_KW = 2048, U2_VW = 2304, U2_G = 2560;
constexpr int OD_N = 8192;
constexpr float EPS = 1e-6f, TINYF = 1e-30f;
constexpr size_t MiB = 1u << 20;
constexpr size_t WS_BAR = 0;
constexpr size_t WS_SMALL = 65536;
constexpr size_t WS_W_EVIN = 1 * MiB, WS_W_EVOUT = 20 * MiB, WS_W_ODIN = 28 * MiB, WS_W_ODOUT = 60 * MiB, WS_W_GU = 68 * MiB, WS_W_DN = 156 * MiB, WS_W_C1 = 200 * MiB;
constexpr size_t WS_HB = 204 * MiB;
constexpr size_t WS_R = 332 * MiB;
constexpr size_t R_HGLU = 0, R_U2 = 64 * MiB, R_ACMP = 240 * MiB, R_HID = 304 * MiB, R_KCMP = 312 * MiB, R_VCMPT = 313 * MiB, R_VST = 314 * MiB, R_VWT = 330 * MiB;
constexpr size_t R_ACT = 0;
constexpr size_t R_UB = 0, R_ZS = 256 * MiB, R_VEC = 384 * MiB, R_ITG = 388 * MiB;
constexpr size_t WS_END = WS_R + 452 * MiB;
constexpr int NWAVES = 8, NTHREADS = 512;
constexpr int LDS_BYTES = 147456;

__device__ __forceinline__ unsigned pk2(float lo, float hi) { return pg8::cvt_pk_bf16(lo, hi); }
__device__ __forceinline__ unsigned f2bf(float f) { return pg8::cvt_pk_bf16(f, 0.f) & 0xffffu; }
__device__ __forceinline__ float bf2f(unsigned h) { return __builtin_bit_cast(float, h << 16); }
__device__ __forceinline__ float bflo(unsigned w) { return __builtin_bit_cast(float, w << 16); }
__device__ __forceinline__ float bfhi(unsigned w) { return __builtin_bit_cast(float, w & 0xffff0000u); }
__device__ __forceinline__ float sigm(float x) { return __builtin_amdgcn_rcpf(1.0f + __expf(-x)); }
#define LDS_WAIT() asm volatile("s_waitcnt lgkmcnt(0)" ::: "memory")
__device__ __forceinline__ f32x4 mfma16(bf16x8 a, bf16x8 b, f32x4 c) { return __builtin_amdgcn_mfma_f32_16x16x32_bf16(a, b, c, 0, 0, 0); }

struct Args { const float* in[20]; float* out; unsigned char* ws; int ph_lo, ph_hi; };
enum { I_X = 0, I_NORMW, I_FNW, I_EVWIN, I_CONVW, I_CONVB, I_LNW, I_LNB, I_CPOS, I_CW1, I_CB1, I_CW2, I_CB2, I_EVWOUT, I_ODWIN, I_GAMMA, I_GNW, I_ODWOUT, I_WGU, I_WDN };

typedef const __attribute__((address_space(4))) Args* KA;
__device__ __forceinline__ int fresh_tid() { int t = threadIdx.x; asm volatile("" : "+v"(t)); return t; }
__device__ __forceinline__ KA fresh_args() { KA p = (KA)__builtin_amdgcn_kernarg_segment_ptr(); asm volatile("" : "+s"(p)); return p; }
#define WSP(ka, off) ((ka)->ws + (off))
#define RP(ka, off) ((ka)->ws + WS_R + (off))


#define XB_TMO      128
#define XB_XCNT(j)  (256  + 64 * (j))
#define XB_XSUB(j)  (1280 + 64 * (j))
#define XB_XGEN(j)  (2304 + 64 * (j))
#define XB_TOP      3328
#define XB_TOPGEN   3392
#define XCD_BAR_WORDS 3456
#define XB_SPIN_CAP (1u << 18)

__device__ __forceinline__ unsigned xb_ld(unsigned* p)              { return __hip_atomic_load(p, __ATOMIC_RELAXED, __HIP_MEMORY_SCOPE_AGENT); }
__device__ __forceinline__ unsigned xb_add(unsigned* p, unsigned v) { return __hip_atomic_fetch_add(p, v, __ATOMIC_RELAXED, __HIP_MEMORY_SCOPE_AGENT); }
__device__ __forceinline__ unsigned xb_xcc_id() { return (unsigned)__builtin_amdgcn_s_getreg((3 << 11) | 20) & 0xFu; }
#define XB_SPIN(cond, bar) do { unsigned _sp = 0; while (cond) { __builtin_amdgcn_s_sleep(1); \
    if ((++_sp & 255u) == 0u) { if (xb_ld(&(bar)[XB_TMO])) break; if (_sp > XB_SPIN_CAP) { atomicAdd(&(bar)[XB_TMO], 1u); break; } } } } while (0)

struct XcdBarrier {
    unsigned* bar; unsigned x;
    volatile LAS unsigned* st;
};

__device__ __forceinline__ XcdBarrier xcd_barrier_post(unsigned* bar, volatile LAS unsigned* st) {
    XcdBarrier b; b.bar = bar; b.x = xb_xcc_id(); b.st = st;
    if (threadIdx.x == 0) (void)xb_add(&bar[XB_XCNT(b.x)], 1u);
    return b;
}
__device__ __forceinline__ void xcd_barrier_complete(unsigned* bar, unsigned x, unsigned& nloc, unsigned& nx) {
    const unsigned G = gridDim.x * gridDim.y * gridDim.z;
    unsigned sum, cnt, mine, sp = 0u;
    for (;;) {
        sum = 0u; cnt = 0u; mine = 0u;
#pragma unroll
        for (unsigned j = 0; j < 16; ++j) { const unsigned c = xb_ld(&bar[XB_XCNT(j)]); sum += c; cnt += (c > 0u) ? 1u : 0u; mine = (j == x) ? c : mine; }
        if (sum == G) break;
        __builtin_amdgcn_s_sleep(1);
        if ((++sp & 255u) == 0u) { if (xb_ld(&bar[XB_TMO])) break; if (sp > XB_SPIN_CAP) { atomicAdd(&bar[XB_TMO], 1u); break; } }
    }
    nloc = mine > 0u ? mine : 1u; nx = cnt > 0u ? cnt : 1u;
}

__device__ __forceinline__ void xcd_barrier(const XcdBarrier& b) {
    asm volatile("s_waitcnt vmcnt(0)" ::: "memory");
    __syncthreads();
    if (threadIdx.x == 0) {
        unsigned* bar = b.bar;
        __builtin_amdgcn_s_waitcnt(0);
        unsigned nloc = b.st[0], nx = b.st[1];
        if (nloc == 0u) { xcd_barrier_complete(bar, b.x, nloc, nx); b.st[0] = nloc; b.st[1] = nx; }
        const unsigned old = xb_add(&bar[XB_XSUB(b.x)], 1u);
        const unsigned gen = old / nloc;
        if (old + 1u == (gen + 1u) * nloc) {
            __builtin_amdgcn_fence(__ATOMIC_RELEASE, "agent");
            asm volatile("s_waitcnt vmcnt(0)" ::: "memory");
            const unsigned og = xb_add(&bar[XB_TOP], 1u);
            const unsigned tg = og / nx;
            if (og + 1u == (tg + 1u) * nx) xb_add(&bar[XB_TOPGEN], 1u);
            else XB_SPIN(xb_ld(&bar[XB_TOPGEN]) == tg, bar);
            __builtin_amdgcn_fence(__ATOMIC_ACQUIRE, "agent");
            xb_add(&bar[XB_XGEN(b.x)], 1u);
            asm volatile("s_waitcnt vmcnt(0)" ::: "memory");
        } else {
            XB_SPIN(xb_ld(&bar[XB_XGEN(b.x)]) == gen, bar);
            __builtin_amdgcn_fence(__ATOMIC_ACQUIRE, "agent");
            asm volatile("s_waitcnt vmcnt(0)" ::: "memory");
        }
    }
    __syncthreads();
}

constexpr int BAR_LDS_OFF = LDS_BYTES - 64;
__device__ __forceinline__ void grid_barrier(LAS unsigned char* lds) {
    XcdBarrier b; b.bar = (unsigned*)(fresh_args()->ws + WS_BAR); b.x = xb_xcc_id(); b.st = (volatile LAS unsigned*)(lds + BAR_LDS_OFF);
    xcd_barrier(b);
}

__device__ __forceinline__ int dest_row(int n, int half, int inter_end) {
    if (n < inter_end) { const int hf = n >= half ? 1 : 0; const int np = n - hf * half; return ((np >> 7) << 8) + hf * 128 + (np & 127); }
    return n;
}
__device__ __forceinline__ void tr_item(const float* W, int K, int N, bf16* WT, LAS float* scr, int item, int lane, int half, int inter_end, int sc_from, int sc_to, float sc) {
    const int nblk = (N + 63) / 64, kb = item / nblk, nb = item % nblk, k0 = 64 * kb, n0 = 64 * nb;
    const int ncol = n0 + lane; const bool okc = ncol < N;
    float wreg[64];
#pragma unroll
    for (int kk = 0; kk < 64; ++kk) wreg[kk] = okc ? W[(size_t)(k0 + kk) * N + ncol] : 0.f;
#pragma unroll
    for (int kk = 0; kk < 64; ++kk) scr[kk * 65 + lane] = wreg[kk];
    LDS_WAIT();
    const int c = lane & 7;
#pragma unroll
    for (int j = 0; j < 8; ++j) { const int n = (lane >> 3) + 8 * j; const LAS float* sp = scr + (8 * c) * 65 + n;
        const int nn = n0 + n; const float s = (nn >= sc_from && nn < sc_to) ? sc : 1.f;
        v4u o; o.x = pk2(sp[0 * 65] * s, sp[1 * 65] * s); o.y = pk2(sp[2 * 65] * s, sp[3 * 65] * s); o.z = pk2(sp[4 * 65] * s, sp[5 * 65] * s); o.w = pk2(sp[6 * 65] * s, sp[7 * 65] * s);
        *(v4u*)(WT + (size_t)dest_row(nn, half, inter_end) * K + k0 + 8 * c) = o; }
    LDS_WAIT();
}
__device__ __forceinline__ float wave_sum(float v) {
    v += __builtin_bit_cast(float, __builtin_amdgcn_mov_dpp(__builtin_bit_cast(int, v), 0xB1, 0xf, 0xf, true));
    v += __builtin_bit_cast(float, __builtin_amdgcn_mov_dpp(__builtin_bit_cast(int, v), 0x4E, 0xf, 0xf, true));
    v += __builtin_bit_cast(float, __builtin_amdgcn_mov_dpp(__builtin_bit_cast(int, v), 0x141, 0xf, 0xf, true));
    v += __builtin_bit_cast(float, __builtin_amdgcn_mov_dpp(__builtin_bit_cast(int, v), 0x140, 0xf, 0xf, true));
    auto s = __builtin_amdgcn_permlane16_swap(__float_as_uint(v), __float_as_uint(v), false, false); v = __uint_as_float(s[0]) + __uint_as_float(s[1]);
    auto t = __builtin_amdgcn_permlane32_swap(__float_as_uint(v), __float_as_uint(v), false, false); return __uint_as_float(t[0]) + __uint_as_float(t[1]);
}
__device__ __forceinline__ void norm_rows(const float* x, const float* w, bf16* outb, float* outf, int gw, int ngw, int lane) {
    f32x4 wv[8];
#pragma unroll
    for (int j = 0; j < 8; ++j) wv[j] = *(const f32x4*)(w + 4 * (lane + 64 * j));
    for (int m = gw; m < T; m += ngw) {
        const f32x4* xr = (const f32x4*)(x + (size_t)m * DM) + lane;
        f32x4 v[8]; float s = 0.f;
#pragma unroll
        for (int j = 0; j < 8; ++j) { v[j] = xr[64 * j]; s += (v[j].x * v[j].x + v[j].y * v[j].y) + (v[j].z * v[j].z + v[j].w * v[j].w); }
        const float rstd = rsqrtf(wave_sum(s) * (1.f / DM) + EPS);
        if (outb) { v2u* o8 = (v2u*)(outb + (size_t)m * DM) + lane;
#pragma unroll
            for (int j = 0; j < 8; ++j) { v2u o; o.x = pk2(v[j].x * rstd * wv[j].x, v[j].y * rstd * wv[j].y); o.y = pk2(v[j].z * rstd * wv[j].z, v[j].w * rstd * wv[j].w); o8[64 * j] = o; } }
        else { f32x4* of = (f32x4*)(outf + (size_t)m * DM) + lane;
#pragma unroll
            for (int j = 0; j < 8; ++j) of[64 * j] = v[j] * rstd * wv[j]; }
    }
}

__device__ __forceinline__ void conv_tile(const bf16* HG, const float* cw, const float* cb, const float* lnw, const float* lnb, bf16* MIX, LAS unsigned char* lds, int tile, int tid) {
    const int lane = tid & 63, wave = tid >> 6;
    const int row0 = tile * 16;
    const int pos0 = row0 & (SEQ - 1);
    const int c0 = tid * 2;
    float w0[31], w1[31];
#pragma unroll
    for (int j = 0; j < 31; ++j) { const f32x2 wv = *(const f32x2*)(cw + j * 1024 + c0); w0[j] = wv.x; w1[j] = wv.y; }
    float a0[16], a1[16];
    const f32x2 bv = *(const f32x2*)(cb + c0);
#pragma unroll
    for (int i = 0; i < 16; ++i) { a0[i] = bv.x; a1[i] = bv.y; }
#pragma unroll
    for (int ri = 0; ri < 46; ++ri) {
        const int p = pos0 - 30 + ri;
        unsigned xw = 0u;
        if (p >= 0) xw = *(const unsigned*)(HG + (size_t)(row0 - 30 + ri) * 1024 + c0);
        const float x0 = bflo(xw), x1 = bfhi(xw);
#pragma unroll
        for (int to = 0; to < 16; ++to) { const int j = ri - to; if (j >= 0 && j <= 30) { a0[to] += w0[j] * x0; a1[to] += w1[j] * x1; } }
    }
    LAS float* tl = (LAS float*)lds;
#pragma unroll
    for (int to = 0; to < 16; ++to) { f32x2 pv2; pv2.x = a0[to]; pv2.y = a1[to]; *(LAS f32x2*)(tl + to * 1024 + c0) = pv2; }
    __syncthreads();
#pragma unroll 1
    for (int q = 0; q < 2; ++q) { const int to = wave * 2 + q; const LAS f32x4* rp = (const LAS f32x4*)(tl + to * 1024) + lane;
        f32x4 v[4]; float s = 0.f;
#pragma unroll
        for (int j = 0; j < 4; ++j) { v[j] = rp[64 * j]; s += (v[j].x + v[j].y) + (v[j].z + v[j].w); }
        const float mu = wave_sum(s) * (1.f / 1024.f); float s2 = 0.f;
#pragma unroll
        for (int j = 0; j < 4; ++j) { v[j] = v[j] - mu; s2 += (v[j].x * v[j].x + v[j].y * v[j].y) + (v[j].z * v[j].z + v[j].w * v[j].w); }
        const float rstd = rsqrtf(wave_sum(s2) * (1.f / 1024.f) + EPS);
        v2u* op = (v2u*)(MIX + (size_t)(row0 + to) * DM) + lane;
#pragma unroll
        for (int j = 0; j < 4; ++j) { const f32x4 lw = *(const f32x4*)(lnw + 4 * (lane + 64 * j)), lb = *(const f32x4*)(lnb + 4 * (lane + 64 * j));
            f32x4 h = v[j] * rstd * lw + lb; h.x = h.x * sigm(h.x); h.y = h.y * sigm(h.y); h.z = h.z * sigm(h.z); h.w = h.w * sigm(h.w);
            v2u o; o.x = pk2(h.x, h.y); o.y = pk2(h.z, h.w); op[64 * j] = o; } }
    __syncthreads();
}

#define BAR_LDS() do { asm volatile("s_waitcnt lgkmcnt(0)" ::: "memory"); __builtin_amdgcn_s_barrier(); asm volatile("" ::: "memory"); } while (0)
__device__ __forceinline__ bf16x8 pack_p(const f32x4& a, const f32x4& b) {
    v4u w; w.x = pg8::cvt_pk_bf16(a[0], a[1]); w.y = pg8::cvt_pk_bf16(a[2], a[3]); w.z = pg8::cvt_pk_bf16(b[0], b[1]); w.w = pg8::cvt_pk_bf16(b[2], b[3]);
    return __builtin_bit_cast(bf16x8, w);
}
constexpr float LOG2E = 1.4426950408889634f;
template <int CTRL> __device__ __forceinline__ float dppf(float x) { return __builtin_bit_cast(float, __builtin_amdgcn_mov_dpp(__builtin_bit_cast(int, x), CTRL, 0xf, 0xf, true)); }
constexpr int DPP_XOR1 = 0xB1, DPP_XOR2 = 0x4E;
__device__ __forceinline__ float xrow16_max(float x) {
    auto s = __builtin_amdgcn_permlane16_swap(__float_as_uint(x), __float_as_uint(x), false, false);
    x = fmaxf(__uint_as_float(s[0]), __uint_as_float(s[1]));
    auto t = __builtin_amdgcn_permlane32_swap(__float_as_uint(x), __float_as_uint(x), false, false);
    return fmaxf(__uint_as_float(t[0]), __uint_as_float(t[1]));
}
template <int CTRL> __device__ __forceinline__ unsigned dppu(unsigned x) { return (unsigned)__builtin_amdgcn_mov_dpp((int)x, CTRL, 0xf, 0xf, true); }
__device__ __forceinline__ unsigned wave_max_u32(unsigned x) {
    x = max(x, dppu<0xB1>(x)); x = max(x, dppu<0x4E>(x)); x = max(x, dppu<0x141>(x)); x = max(x, dppu<0x140>(x));
    auto s = __builtin_amdgcn_permlane16_swap(x, x, false, false); x = max((unsigned)s[0], (unsigned)s[1]);
    auto t = __builtin_amdgcn_permlane32_swap(x, x, false, false); return max((unsigned)t[0], (unsigned)t[1]);
}
__device__ __forceinline__ float xrow16_sum(float x) {
    auto s = __builtin_amdgcn_permlane16_swap(__float_as_uint(x), __float_as_uint(x), false, false);
    x = __uint_as_float(s[0]) + __uint_as_float(s[1]);
    auto t = __builtin_amdgcn_permlane32_swap(__float_as_uint(x), __float_as_uint(x), false, false);
    return __uint_as_float(t[0]) + __uint_as_float(t[1]);
}
constexpr int KT_LD = 72;
constexpr int NSA_WSTRIDE = 8448, NSA_TILE0 = 8 * NSA_WSTRIDE, NSA_TILE_STRIDE = 18432, NSA_V_OFF = 9216, NSA_XCH = NSA_TILE0 + 2 * NSA_TILE_STRIDE;
__device__ __forceinline__ int pop_bit(u64& u0, u64& u1, u64& u2, u64& u3) {
    if (u0) { const int j = __builtin_ctzll(u0); u0 &= u0 - 1; return j; }
    if (u1) { const int j = __builtin_ctzll(u1); u1 &= u1 - 1; return 64 + j; }
    if (u2) { const int j = __builtin_ctzll(u2); u2 &= u2 - 1; return 128 + j; }
    if (u3) { const int j = __builtin_ctzll(u3); u3 &= u3 - 1; return 192 + j; }
    return -1;
}
template <int MODE>
__device__ __forceinline__ void nsa_soft(f32x4 (&st)[4], const float (&Bl)[16], float cl, bool fast, int keybase, int t, bool sel, float& m2, float& l, f32x4 (&o)[4], float lfin, LAS float* imp, int lane) {
    const int kg = lane >> 4;
#pragma unroll
    for (int tau = 0; tau < 4; ++tau)
#pragma unroll
        for (int r = 0; r < 4; ++r) st[tau][r] = __builtin_fmaf(st[tau][r], LOG2E, Bl[tau * 4 + r]);
    if (!fast) {
#pragma unroll
        for (int tau = 0; tau < 4; ++tau)
#pragma unroll
            for (int r = 0; r < 4; ++r) { const int off = keybase + 32 * (tau >> 1) + 8 * kg + 4 * (tau & 1) + r;
                int dist; bool valid;
                if (MODE <= 1) { dist = t - (16 * off + 31); valid = dist >= 0; }
                else if (MODE == 2) { dist = t - off; valid = sel && dist >= 0; }
                else { dist = t - off; valid = dist >= 0 && dist < 512; }
                st[tau][r] = valid ? st[tau][r] : -INFINITY; }
    }
    if (MODE == 1) {
        const float sh = cl - lfin;
#pragma unroll
        for (int tau = 0; tau < 4; ++tau) {
#pragma unroll
            for (int r = 0; r < 4; ++r) st[tau][r] = __builtin_amdgcn_exp2f(st[tau][r] + sh);
            float ps = (st[tau][0] + st[tau][1]) + (st[tau][2] + st[tau][3]), p3 = st[tau][3];
            ps += dppf<DPP_XOR1>(ps); ps += dppf<DPP_XOR2>(ps); p3 += dppf<DPP_XOR1>(p3); p3 += dppf<DPP_XOR2>(p3);
            const int j0 = (keybase >> 2) + 8 * (tau >> 1) + 2 * kg + (tau & 1);
            if ((lane & 3) == 0) { const int tk = (lane & 15) >> 2; imp[tk * 256 + j0] += ps; if (j0 + 1 < 256) imp[tk * 256 + j0 + 1] += p3; }
        }
    } else {
        float mloc = fmaxf(fmaxf(fmaxf(st[0][0], st[0][1]), fmaxf(st[0][2], st[0][3])), fmaxf(fmaxf(st[1][0], st[1][1]), fmaxf(st[1][2], st[1][3])));
        mloc = fmaxf(mloc, fmaxf(fmaxf(fmaxf(st[2][0], st[2][1]), fmaxf(st[2][2], st[2][3])), fmaxf(fmaxf(st[3][0], st[3][1]), fmaxf(st[3][2], st[3][3]))));
        mloc = xrow16_max(mloc);
        const float mnew = fmaxf(m2, mloc + cl); const float alpha = __builtin_amdgcn_exp2f(m2 - mnew); m2 = mnew;
        const float sh = cl - mnew;
        float ps = 0.f;
#pragma unroll
        for (int tau = 0; tau < 4; ++tau)
#pragma unroll
            for (int r = 0; r < 4; ++r) { const float p = __builtin_amdgcn_exp2f(st[tau][r] + sh); st[tau][r] = p; ps += p; }
        l = l * alpha + ps;
        if (MODE != 0) {
#pragma unroll
            for (int dt = 0; dt < 4; ++dt) o[dt] = o[dt] * alpha;
        }
    }
}
template <int MODE>
__device__ __forceinline__ void attn_step2(const LAS bf16* kt, const LAS bf16* vt, const bf16x8 (&qf)[2][2], const float (&Bl)[16], const float (&cl)[2], bool fast, int keybase, const int (&t)[2], const bool (&sel)[2],
                                           float (&m2)[2], float (&l)[2], f32x4 (&o)[2][4], const float (&lfin)[2], LAS float* imp, int lane) {
    const int kg = lane >> 4;
    f32x4 st[2][4];
    { const int rho = lane & 15, dof = kg * 8;
#pragma unroll
      for (int tau = 0; tau < 4; ++tau) { const LAS bf16* rp = kt + (16 * tau + rho) * KT_LD + dof;
          const bf16x8 k0 = *(const LAS bf16x8*)(rp), k1 = *(const LAS bf16x8*)(rp + 32);
#pragma unroll
          for (int s = 0; s < 2; ++s) { st[s][tau] = (f32x4){0.f, 0.f, 0.f, 0.f}; st[s][tau] = mfma16(k0, qf[s][0], st[s][tau]); st[s][tau] = mfma16(k1, qf[s][1], st[s][tau]); } } }
#pragma unroll
    for (int s = 0; s < 2; ++s) nsa_soft<MODE>(st[s], Bl, cl[s], fast, keybase, t[s], sel[s], m2[s], l[s], o[s], lfin[s], imp + s * 1024, lane);
    if (MODE != 0) {
        bf16x8 pb[2][2];
#pragma unroll
        for (int s = 0; s < 2; ++s) { pb[s][0] = pack_p(st[s][0], st[s][1]); pb[s][1] = pack_p(st[s][2], st[s][3]); }
#pragma unroll
        for (int dt = 0; dt < 4; ++dt) { const LAS bf16* vp = vt + (dt * 16 + (lane & 15)) * KT_LD + 8 * kg;
            const bf16x8 v0 = *(const LAS bf16x8*)(vp), v1 = *(const LAS bf16x8*)(vp + 32);
#pragma unroll
            for (int s = 0; s < 2; ++s) { o[s][dt] = mfma16(v0, pb[s][0], o[s][dt]); o[s][dt] = mfma16(v1, pb[s][1], o[s][dt]); } }
    }
}
template <int MODE>
__device__ __forceinline__ void dense_branch(LAS unsigned char* lds, const bf16* kbase, int ldk, const bf16* vbase, int ldv, int kb0, int nst, int tid, int lane,
                                             const bf16x8 (&qf)[2][2], const int (&t)[2], int tmin, float sl2, float (&m)[2], float (&l)[2], f32x4 (&o)[2][4], const float (&lfin)[2], LAS float* imp) {
    float Bl[16];
#pragma unroll
    for (int tau = 0; tau < 4; ++tau)
#pragma unroll
        for (int r = 0; r < 4; ++r) Bl[tau * 4 + r] = sl2 * (float)((MODE <= 1 ? 16 : 1) * (32 * (tau >> 1) + 8 * (lane >> 4) + 4 * (tau & 1) + r));
    const int srow = tid >> 3, sch = (tid & 7) * 8;
    const int krow = 16 * (2 * (srow >> 5) + ((srow >> 2) & 1)) + 4 * ((srow >> 3) & 3) + (srow & 3);
    const bool selt[2] = {true, true};
    v4u skA, svA;
#define DB_GLOAD(SK, SV, kb_) do { SK = *(const v4u*)(kbase + (size_t)((kb_) + srow) * ldk + sch); if (MODE != 0) SV = *(const v4u*)(vbase + (size_t)srow * ldv + (kb_) + sch); } while (0)
#define DB_LWRITE(SK, SV, buf_) do { LAS unsigned char* nb_ = lds + NSA_TILE0 + (buf_) * NSA_TILE_STRIDE; *(LAS v4u*)((LAS bf16*)nb_ + krow * KT_LD + sch) = SK; if (MODE != 0) *(LAS v4u*)((LAS bf16*)(nb_ + NSA_V_OFF) + srow * KT_LD + sch) = SV; } while (0)
#define DB_COMPUTE(kb_, buf_) do { const int kbb = (kb_); LAS unsigned char* cb_ = lds + NSA_TILE0 + (buf_) * NSA_TILE_STRIDE; \
        float cl[2]; cl[0] = (MODE <= 1) ? sl2 * (float)(16 * kbb + 31 - t[0]) : sl2 * (float)(kbb - t[0]); cl[1] = (MODE <= 1) ? sl2 * (float)(16 * kbb + 31 - t[1]) : sl2 * (float)(kbb - t[1]); \
        const bool fast = (MODE <= 1) ? (16 * (kbb + 63) + 31 <= tmin) : (kbb + 63 <= tmin && tmin + 7 - kbb < 512); \
        attn_step2<MODE>((const LAS bf16*)cb_, (const LAS bf16*)(cb_ + NSA_V_OFF), qf, Bl, cl, fast, kbb, t, selt, m, l, o, lfin, imp, lane); } while (0)
    if (nst > 0) { DB_GLOAD(skA, svA, kb0); DB_LWRITE(skA, svA, 0); }
    BAR_LDS();
#pragma unroll 1
    for (int s = 0; s < nst; ++s) {
        const int kb = kb0 + s * 64;
        if (s + 1 < nst) DB_GLOAD(skA, svA, kb + 64);
        DB_COMPUTE(kb, s & 1);
        if (s + 1 < nst) DB_LWRITE(skA, svA, (s + 1) & 1);
        BAR_LDS();
    }
#undef DB_GLOAD
#undef DB_LWRITE
#undef DB_COMPUTE
}
__device__ __forceinline__ void nsa_block(LAS unsigned char* lds, int b, int g, int t0b, int tid) {
    const int lane = tid & 63, wave = __builtin_amdgcn_readfirstlane(tid >> 6);
    LAS float* wl = (LAS float*)(lds + wave * NSA_WSTRIDE);
    const int t0 = t0b + 8 * wave;
    const int qi = lane & 15, kg = lane >> 4, tok = qi >> 2, hd = qi & 3;
    const int head = g * 4 + hd;
    const int t[2] = {t0 + tok, t0 + 4 + tok};
    const float sl2 = exp2f(-0.5f * (float)(head + 1)) * LOG2E;
    const size_t rowb = (size_t)b * SEQ;
    const int bg = b * 4 + g;
    bf16x8 qf[2][2];
    { const bf16* U2 = (const bf16*)(fresh_args()->ws + WS_R + R_U2);
#pragma unroll
      for (int s = 0; s < 2; ++s) { const bf16* qrow = U2 + (rowb + t[s]) * U2_LD + U2_Q + head * 64 + kg * 8; qf[s][0] = *(const bf16x8*)qrow; qf[s][1] = *(const bf16x8*)(qrow + 32); } }
#define NSA_GATE(s_, br_) sigm(bf2f(((const bf16*)(fresh_args()->ws + WS_R + R_U2))[(rowb + t[s_]) * U2_LD + U2_G + (br_) * 16 + head]))
    f32x4 o[2][4];
    LAS float* imp = wl;
    LAS f32x4* RES = (LAS f32x4*)wl;
    LAS u64* SELM = (LAS u64*)(wl + 2048);
#pragma unroll
    for (int i = 0; i < 8; ++i) *(LAS f32x4*)(imp + (i * 64 + lane) * 4) = (f32x4){0.f, 0.f, 0.f, 0.f};
    const int cur = t0b >> 6;
    const float zero2[2] = {0.f, 0.f};
    {
        unsigned char* wsr = fresh_args()->ws + WS_R;
        const bf16* kc = (const bf16*)(wsr + R_KCMP) + (size_t)bg * 1024 * 64; const bf16* vct = (const bf16*)(wsr + R_VCMPT) + (size_t)bg * 64 * 1024;
        const int nsteps = (((t0b + 32) >> 4) >> 6) + 1;
        float m[2] = {-1e30f, -1e30f}, l[2] = {0.f, 0.f};
        dense_branch<0>(lds, kc, 64, vct, 1024, 0, nsteps, tid, lane, qf, t, t0, sl2, m, l, o, zero2, imp);
        float lfin[2];
#pragma unroll
        for (int s = 0; s < 2; ++s) { l[s] = xrow16_sum(l[s]); lfin[s] = m[s] + __builtin_amdgcn_logf(fmaxf(l[s], TINYF));
#pragma unroll
            for (int dt = 0; dt < 4; ++dt) o[s][dt] = (f32x4){0.f, 0.f, 0.f, 0.f}; }
        dense_branch<1>(lds, kc, 64, vct, 1024, 0, nsteps, tid, lane, qf, t, t0, sl2, m, l, o, lfin, imp);
#pragma unroll
        for (int s = 0; s < 2; ++s)
#pragma unroll
            for (int dt = 0; dt < 4; ++dt) o[s][dt] = o[s][dt] * NSA_GATE(s, 0);
    }
    LDS_WAIT();
    u64 w0 = 0ull, w1 = 0ull, w2 = 0ull, w3 = 0ull;
    {
        const int ncand = cur - 2 > 0 ? cur - 2 : 0; const int nsel = ncand < 13 ? ncand : 13;
#pragma unroll 1
        for (int tk = 0; tk < 8; ++tk) {
            unsigned k0 = 0u, k1 = 0u, k2 = 0u, k3 = 0u;
            { const int j0 = lane, j1 = lane + 64, j2 = lane + 128, j3 = lane + 192;
              if (j0 >= 1 && j0 <= cur - 2) k0 = (__float_as_uint(imp[tk * 256 + j0]) & 0xffffff00u) | (unsigned)(255 - j0);
              if (j1 <= cur - 2) k1 = (__float_as_uint(imp[tk * 256 + j1]) & 0xffffff00u) | (unsigned)(255 - j1);
              if (j2 <= cur - 2) k2 = (__float_as_uint(imp[tk * 256 + j2]) & 0xffffff00u) | (unsigned)(255 - j2);
              if (j3 <= cur - 2) k3 = (__float_as_uint(imp[tk * 256 + j3]) & 0xffffff00u) | (unsigned)(255 - j3); }
            unsigned sb = 0u;
            for (int it = 0; it < nsel; ++it) {
                const unsigned best = wave_max_u32(max(max(k0, k1), max(k2, k3)));
                const int bi = 255 - (int)(best & 0xffu);
                if ((bi & 63) == lane) { const int ii = bi >> 6; sb |= 1u << ii; if (ii == 0) k0 = 0u; else if (ii == 1) k1 = 0u; else if (ii == 2) k2 = 0u; else k3 = 0u; }
            }
            u64 m0 = __ballot((sb & 1u) != 0u), m1 = __ballot((sb & 2u) != 0u), m2 = __ballot((sb & 4u) != 0u), m3 = __ballot((sb & 8u) != 0u);
            m0 |= 1ull;
            { const int w = cur >> 6; const u64 bit = 1ull << (cur & 63); if (w == 0) m0 |= bit; else if (w == 1) m1 |= bit; else if (w == 2) m2 |= bit; else m3 |= bit; }
            if (cur >= 1) { const int c1 = cur - 1; const int w = c1 >> 6; const u64 bit = 1ull << (c1 & 63); if (w == 0) m0 |= bit; else if (w == 1) m1 |= bit; else if (w == 2) m2 |= bit; else m3 |= bit; }
            if (lane == 0) { SELM[tk * 4 + 0] = m0; SELM[tk * 4 + 1] = m1; SELM[tk * 4 + 2] = m2; SELM[tk * 4 + 3] = m3; }
            w0 |= m0; w1 |= m1; w2 |= m2; w3 |= m3;
        }
    }
#pragma unroll
    for (int s = 0; s < 2; ++s)
#pragma unroll
        for (int dt = 0; dt < 4; ++dt) RES[(s * 4 + dt) * 64 + lane] = o[s][dt];
    LAS u64* XCH = (LAS u64*)(lds + NSA_XCH);
    if (lane == 0) { XCH[wave * 4 + 0] = w0; XCH[wave * 4 + 1] = w1; XCH[wave * 4 + 2] = w2; XCH[wave * 4 + 3] = w3; }
    BAR_LDS();
    u64 u0 = 0ull, u1 = 0ull, u2 = 0ull, u3 = 0ull;
#pragma unroll
    for (int w = 0; w < 8; ++w) { u0 |= XCH[w * 4 + 0]; u1 |= XCH[w * 4 + 1]; u2 |= XCH[w * 4 + 2]; u3 |= XCH[w * 4 + 3]; }
    u0 = ((u64)__builtin_amdgcn_readfirstlane((unsigned)(u0 >> 32)) << 32) | (u64)__builtin_amdgcn_readfirstlane((unsigned)u0);
    u1 = ((u64)__builtin_amdgcn_readfirstlane((unsigned)(u1 >> 32)) << 32) | (u64)__builtin_amdgcn_readfirstlane((unsigned)u1);
    u2 = ((u64)__builtin_amdgcn_readfirstlane((unsigned)(u2 >> 32)) << 32) | (u64)__builtin_amdgcn_readfirstlane((unsigned)u2);
    u3 = ((u64)__builtin_amdgcn_readfirstlane((unsigned)(u3 >> 32)) << 32) | (u64)__builtin_amdgcn_readfirstlane((unsigned)u3);
    {
        unsigned char* wsr = fresh_args()->ws + WS_R;
        const bf16* ksb = (const bf16*)(wsr + R_U2) + rowb * U2_LD + U2_KS + g * 64; const bf16* vsb = (const bf16*)(wsr + R_VST) + (size_t)bg * 64 * SEQ;
        float m[2] = {-1e30f, -1e30f}, l[2] = {0.f, 0.f};
#pragma unroll
        for (int s = 0; s < 2; ++s)
#pragma unroll
            for (int dt = 0; dt < 4; ++dt) o[s][dt] = (f32x4){0.f, 0.f, 0.f, 0.f};
        const int srow = tid >> 3, sch = (tid & 7) * 8;
        const int krow = 16 * (2 * (srow >> 5) + ((srow >> 2) & 1)) + 4 * ((srow >> 3) & 3) + (srow & 3);
        v4u skA, svA;
        float Bl[16];
#pragma unroll
        for (int tau = 0; tau < 4; ++tau)
#pragma unroll
            for (int r = 0; r < 4; ++r) Bl[tau * 4 + r] = sl2 * (float)(32 * (tau >> 1) + 8 * kg + 4 * (tau & 1) + r);
#define SL_GLOAD(SK, SV, j_) do { SK = *(const v4u*)(ksb + (size_t)((j_) * 64 + srow) * U2_LD + sch); SV = *(const v4u*)(vsb + (size_t)srow * SEQ + (j_) * 64 + sch); } while (0)
#define SL_LWRITE(SK, SV, buf_) do { LAS unsigned char* nb_ = lds + NSA_TILE0 + (buf_) * NSA_TILE_STRIDE; *(LAS v4u*)((LAS bf16*)nb_ + krow * KT_LD + sch) = SK; *(LAS v4u*)((LAS bf16*)(nb_ + NSA_V_OFF) + srow * KT_LD + sch) = SV; } while (0)
#define SL_COMPUTE(j_, buf_) do { const int jj = (j_); const int wd = jj >> 6; const u64 wword = wd == 0 ? w0 : wd == 1 ? w1 : wd == 2 ? w2 : w3; \
            if ((wword >> (jj & 63)) & 1ull) { LAS unsigned char* cb_ = lds + NSA_TILE0 + (buf_) * NSA_TILE_STRIDE; \
                bool sel[2]; sel[0] = ((SELM[tok * 4 + wd] >> (jj & 63)) & 1ull) != 0ull; sel[1] = ((SELM[(tok + 4) * 4 + wd] >> (jj & 63)) & 1ull) != 0ull; \
                const bool fast = (jj < cur);     \
                float cl[2]; cl[0] = (sel[0] || !fast) ? sl2 * (float)(jj * 64 - t[0]) : -INFINITY; cl[1] = (sel[1] || !fast) ? sl2 * (float)(jj * 64 - t[1]) : -INFINITY; \
                attn_step2<2>((const LAS bf16*)cb_, (const LAS bf16*)(cb_ + NSA_V_OFF), qf, Bl, cl, fast, jj * 64, t, sel, m, l, o, zero2, imp, lane); } } while (0)
        int jc = pop_bit(u0, u1, u2, u3);
        SL_GLOAD(skA, svA, jc); SL_LWRITE(skA, svA, 0);
        BAR_LDS();
        int sidx = 0;
#pragma unroll 1
        while (jc >= 0) {
            const int jn = pop_bit(u0, u1, u2, u3);
            if (jn >= 0) SL_GLOAD(skA, svA, jn);
            SL_COMPUTE(jc, sidx & 1);
            if (jn >= 0) SL_LWRITE(skA, svA, (sidx + 1) & 1);
            BAR_LDS();
            jc = jn; ++sidx;
        }
#undef SL_GLOAD
#undef SL_LWRITE
#undef SL_COMPUTE
#pragma unroll
        for (int s = 0; s < 2; ++s) { l[s] = xrow16_sum(l[s]); const float sc = NSA_GATE(s, 1) * __builtin_amdgcn_rcpf(fmaxf(l[s], TINYF));
#pragma unroll
            for (int dt = 0; dt < 4; ++dt) RES[(s * 4 + dt) * 64 + lane] = RES[(s * 4 + dt) * 64 + lane] + o[s][dt] * sc; }
    }
    {
        unsigned char* wsr = fresh_args()->ws + WS_R;
        const bf16* kwb = (const bf16*)(wsr + R_U2) + rowb * U2_LD + U2_KW + g * 64; const bf16* vwb = (const bf16*)(wsr + R_VWT) + (size_t)bg * 64 * SEQ;
        const int lo = t0b - 511 > 0 ? t0b - 511 : 0; const int base0 = lo & ~63; const int nsteps = ((t0b + 63) >> 6) - (base0 >> 6) + 1;
        float m[2] = {-1e30f, -1e30f}, l[2] = {0.f, 0.f};
#pragma unroll
        for (int s = 0; s < 2; ++s)
#pragma unroll
            for (int dt = 0; dt < 4; ++dt) o[s][dt] = (f32x4){0.f, 0.f, 0.f, 0.f};
        dense_branch<3>(lds, kwb, U2_LD, vwb, SEQ, base0, nsteps, tid, lane, qf, t, t0, sl2, m, l, o, zero2, imp);
#pragma unroll
        for (int s = 0; s < 2; ++s) { l[s] = xrow16_sum(l[s]); const float sc = NSA_GATE(s, 2) * __builtin_amdgcn_rcpf(fmaxf(l[s], TINYF));
#pragma unroll
            for (int dt = 0; dt < 4; ++dt) o[s][dt] = RES[(s * 4 + dt) * 64 + lane] + o[s][dt] * sc; }
    }
#pragma unroll
    for (int s = 0; s < 2; ++s) { bf16* orow = (bf16*)(fresh_args()->ws + WS_HB) + (rowb + t[s]) * DM + 1024 + head * 64 + kg * 4;
#pragma unroll
        for (int dt = 0; dt < 4; ++dt) { v2u w; w.x = pk2(o[s][dt][0], o[s][dt][1]); w.y = pk2(o[s][dt][2], o[s][dt][3]); *(v2u*)(orow + dt * 16) = w; } }
}
constexpr int QLD = 136, TLD = 72;
constexpr int H_QT = 0, H_KT = 17408, H_KTT = 34816, H_IT = 53248, H_SEG = 71680, H_DB = 73728, H_GN = 74240, H_RAWQ = 76800, H_RAWF = 93184, H_RAWI = 109568;
struct HTiles { v4u a[2], b[2], c[2]; };
__device__ __forceinline__ void hgrn_load_raw(HTiles& R, const bf16* UB, int unit, int tid) {
    const int h = unit >> 8, s0 = (unit & 255) * 64;
#pragma unroll
    for (int i = 0; i < 2; ++i) { const int cix = tid + 512 * i, row = cix >> 4, ch = (cix & 15) * 8; const bf16* gp = UB + (size_t)(s0 + row) * OD_N + h * 128 + ch;
        R.a[i] = *(const v4u*)gp; R.b[i] = *(const v4u*)(gp + 2048); R.c[i] = *(const v4u*)(gp + 4096); }
}
__device__ __forceinline__ void hgrn_prep(const HTiles& R, const float* gamma, int h, LAS unsigned char* lds, int tid, float* vec) {
    const int k = tid & 127, seg = tid >> 7, col = h * 128 + k;
    const float lb = 1.0f / (1.0f + __expf(gamma[col] - gamma[2048 + col]));
    LAS float* SEG = (LAS float*)(lds + H_SEG);
    LAS bf16* QT = (LAS bf16*)(lds + H_QT); LAS bf16* KT = (LAS bf16*)(lds + H_KT); LAS bf16* KTT = (LAS bf16*)(lds + H_KTT); LAS bf16* IT = (LAS bf16*)(lds + H_IT);
    float lf[16], kk[16], qv[16]; unsigned iv[16];
    { LAS bf16* RQ = (LAS bf16*)(lds + H_RAWQ); LAS bf16* RF = (LAS bf16*)(lds + H_RAWF); LAS bf16* RI = (LAS bf16*)(lds + H_RAWI);
#pragma unroll
      for (int i = 0; i < 2; ++i) { const int cix = tid + 512 * i, row = cix >> 4, ch = (cix & 15) * 8;
          *(LAS v4u*)(RQ + row * 128 + ch) = R.a[i]; *(LAS v4u*)(RF + row * 128 + ch) = R.b[i]; *(LAS v4u*)(RI + row * 128 + ch) = R.c[i]; }
      BAR_LDS();
#pragma unroll
      for (int j = 0; j < 16; ++j) { const int ro = (seg * 16 + j) * 128 + k; qv[j] = bf2f(RQ[ro]); const float x = bf2f(RF[ro]); iv[j] = RI[ro];
          const float f = lb + (1.0f - lb) * sigm(x); lf[j] = __builtin_amdgcn_logf(fmaxf(f, TINYF)) * 0.6931471805599453f; kk[j] = 1.0f - f; } }
    float c = 0.f;
#pragma unroll
    for (int j = 0; j < 16; ++j) { c += lf[j]; lf[j] = c; }
    SEG[seg * 128 + k] = c;
    BAR_LDS();
    const float s0v = SEG[k], s1v = SEG[128 + k], s2v = SEG[256 + k], s3v = SEG[384 + k];
    const float pre = seg == 0 ? 0.f : seg == 1 ? s0v : seg == 2 ? s0v + s1v : s0v + s1v + s2v;
    const float gref = s0v + s1v, glast = (s0v + s1v) + (s2v + s3v);
    unsigned kt16[16];
#pragma unroll
    for (int j = 0; j < 16; ++j) { const float G = pre + lf[j]; const unsigned qb = f2bf(qv[j] * __expf(G - gref)), kb = f2bf(kk[j] * __expf(gref - G));
        QT[(seg * 16 + j) * QLD + k] = (bf16)qb; KT[(seg * 16 + j) * QLD + k] = (bf16)kb; kt16[j] = kb; }
    { v4u a, b2; a.x = kt16[0] | (kt16[1] << 16); a.y = kt16[2] | (kt16[3] << 16); a.z = kt16[4] | (kt16[5] << 16); a.w = kt16[6] | (kt16[7] << 16);
      b2.x = kt16[8] | (kt16[9] << 16); b2.y = kt16[10] | (kt16[11] << 16); b2.z = kt16[12] | (kt16[13] << 16); b2.w = kt16[14] | (kt16[15] << 16);
      *(LAS v4u*)(KTT + k * TLD + seg * 16) = a; *(LAS v4u*)(KTT + k * TLD + seg * 16 + 8) = b2; }
    { v4u a, b2; a.x = iv[0] | (iv[1] << 16); a.y = iv[2] | (iv[3] << 16); a.z = iv[4] | (iv[5] << 16); a.w = iv[6] | (iv[7] << 16);
      b2.x = iv[8] | (iv[9] << 16); b2.y = iv[10] | (iv[11] << 16); b2.z = iv[12] | (iv[13] << 16); b2.w = iv[14] | (iv[15] << 16);
      *(LAS v4u*)(IT + k * TLD + seg * 16) = a; *(LAS v4u*)(IT + k * TLD + seg * 16 + 8) = b2; }
    if (seg == 0) { ((LAS float*)(lds + H_DB))[k] = __expf(glast - gref); if (vec) { vec[k] = __expf(glast); vec[128 + k] = __expf(gref); } }
    BAR_LDS();
}
__device__ __forceinline__ void hgrn_passA(bf16* UB, const float* gamma, bf16* ZS, float* VEC, bf16* ITG, int unit, const HTiles& R, LAS unsigned char* lds, int tid) {
    const int h = unit >> 8, c = unit & 255, lane = tid & 63, w = tid >> 6;
    hgrn_prep(R, gamma, h, lds, tid, VEC + (size_t)unit * 256);
    const LAS bf16* KTT = (const LAS bf16*)(lds + H_KTT); const LAS bf16* IT = (const LAS bf16*)(lds + H_IT); const LAS float* DB = (const LAS float*)(lds + H_DB);
    f32x4 acc[8];
#pragma unroll
    for (int vt = 0; vt < 8; ++vt) acc[vt] = (f32x4){0.f, 0.f, 0.f, 0.f};
#pragma unroll
    for (int ks = 0; ks < 2; ++ks) { const bf16x8 a = *(const LAS bf16x8*)(KTT + (16 * w + (lane & 15)) * TLD + 32 * ks + 8 * (lane >> 4));
#pragma unroll
        for (int vt = 0; vt < 8; ++vt) { const bf16x8 bb = *(const LAS bf16x8*)(IT + (16 * vt + (lane & 15)) * TLD + 32 * ks + 8 * (lane >> 4)); acc[vt] = mfma16(a, bb, acc[vt]); } }
    const int k0 = 16 * w + 4 * (lane >> 4);
    const float d0 = DB[k0], d1 = DB[k0 + 1], d2 = DB[k0 + 2], d3 = DB[k0 + 3];
#pragma unroll
    for (int vt = 0; vt < 8; ++vt) { const int v = 16 * vt + (lane & 15); v2u o; o.x = pk2(acc[vt][0] * d0, acc[vt][1] * d1); o.y = pk2(acc[vt][2] * d2, acc[vt][3] * d3);
        *(v2u*)(ZS + ((size_t)unit * 128 + v) * 128 + k0) = o; }
    { const LAS bf16* QT = (const LAS bf16*)(lds + H_QT); const LAS bf16* KT = (const LAS bf16*)(lds + H_KT);
#pragma unroll
      for (int i = 0; i < 2; ++i) { const int cix = tid + 512 * i, row = cix >> 4, ch = (cix & 15) * 8; bf16* gp = UB + (size_t)(c * 64 + row) * OD_N + h * 128 + ch;
          *(v4u*)gp = *(const LAS v4u*)(QT + row * QLD + ch); *(v4u*)(gp + 2048) = *(const LAS v4u*)(KT + row * QLD + ch); }
#pragma unroll
      for (int i = 0; i < 2; ++i) { const int cix = tid + 512 * i, v = cix >> 3, ch = (cix & 7) * 8; *(v4u*)(ITG + (size_t)unit * 8192 + v * 64 + ch) = *(const LAS v4u*)(IT + v * TLD + ch); } }
    BAR_LDS();
}
__device__ __forceinline__ void hgrn_scan(bf16* ZS, const float* VEC, int gthread, int nthreads) {
    for (int e2 = gthread; e2 < 16 * 8192; e2 += nthreads) {
        const int h = e2 >> 13, rem = (e2 & 8191) * 2, k = rem & 127;
        float st0 = 0.f, st1 = 0.f;
        for (int c0 = 0; c0 < 256; c0 += 32) {
            unsigned z[32]; f32x2 da[32], dc[32];
#pragma unroll
            for (int i = 0; i < 32; ++i) { const size_t unit = (size_t)h * 256 + c0 + i; z[i] = *(const unsigned*)(ZS + unit * 16384 + rem); da[i] = *(const f32x2*)(VEC + unit * 256 + k); dc[i] = *(const f32x2*)(VEC + unit * 256 + 128 + k); }
#pragma unroll
            for (int i = 0; i < 32; ++i) { const size_t unit = (size_t)h * 256 + c0 + i; *(unsigned*)(ZS + unit * 16384 + rem) = pk2(dc[i].x * st0, dc[i].y * st1);
                st0 = da[i].x * st0 + bflo(z[i]); st1 = da[i].y * st1 + bfhi(z[i]); }
        }
    }
}
__device__ __forceinline__ void hgrn_load_c(HTiles& R, const bf16* UB, const bf16* ITG, int unit, int tid) {
    const int h = unit >> 8, c = unit & 255;
#pragma unroll
    for (int i = 0; i < 2; ++i) { const int cix = tid + 512 * i, row = cix >> 4, ch = (cix & 15) * 8; const bf16* gp = UB + (size_t)(c * 64 + row) * OD_N + h * 128 + ch;
        R.a[i] = *(const v4u*)gp; R.b[i] = *(const v4u*)(gp + 2048); R.c[i] = *(const v4u*)(ITG + (size_t)unit * 8192 + (size_t)cix * 8); }
}
__device__ __forceinline__ void hgrn_passC(const bf16* UB, const bf16* ITG, const bf16* ZS, const float* gw, bf16* MIXB, int unit, int next_unit, HTiles& R, LAS unsigned char* lds, int tid) {
    const int h = unit >> 8, c = unit & 255, lane = tid & 63, w = tid >> 6, tt = w & 3, vh = w >> 2, kg = lane >> 4, tq = lane & 15;
    const int tl = 16 * tt + tq; const size_t row = (size_t)c * 64 + tl;
    { LAS bf16* QTw = (LAS bf16*)(lds + H_QT); LAS bf16* KTw = (LAS bf16*)(lds + H_KT); LAS bf16* ITw = (LAS bf16*)(lds + H_IT);
#pragma unroll
      for (int i = 0; i < 2; ++i) { const int cix = tid + 512 * i, rw = cix >> 4, ch = (cix & 15) * 8;
          *(LAS v4u*)(QTw + rw * QLD + ch) = R.a[i]; *(LAS v4u*)(KTw + rw * QLD + ch) = R.b[i]; *(LAS v4u*)(ITw + (cix >> 3) * TLD + (cix & 7) * 8) = R.c[i]; } }
    bf16x8 sf[4][4]; v2u gg[4];
#pragma unroll
    for (int vt = 0; vt < 4; ++vt) { const int vrow = 64 * vh + 16 * vt + tq; const bf16* sp = ZS + ((size_t)unit * 128 + vrow) * 128 + 8 * kg;
#pragma unroll
        for (int ks = 0; ks < 4; ++ks) sf[vt][ks] = *(const bf16x8*)(sp + 32 * ks);
        gg[vt] = *(const v2u*)(UB + row * OD_N + 6144 + h * 128 + 64 * vh + 16 * vt + 4 * kg); }
    BAR_LDS();
    if (next_unit >= 0) hgrn_load_c(R, UB, ITG, next_unit, tid);
    const LAS bf16* QT = (const LAS bf16*)(lds + H_QT); const LAS bf16* KT = (const LAS bf16*)(lds + H_KT); const LAS bf16* IT = (const LAS bf16*)(lds + H_IT); LAS float* GN = (LAS float*)(lds + H_GN);
    bf16x8 qf[4];
#pragma unroll
    for (int ks = 0; ks < 4; ++ks) qf[ks] = *(const LAS bf16x8*)(QT + (16 * tt + tq) * QLD + 32 * ks + 8 * kg);
    f32x4 st[4];
    const int ro = 8 * (tq >> 2) + (tq & 3);
#pragma unroll
    for (int tau = 0; tau < 4; ++tau) { st[tau] = (f32x4){0.f, 0.f, 0.f, 0.f}; const int srow = 32 * (tau >> 1) + 4 * (tau & 1) + ro;
#pragma unroll
        for (int ks = 0; ks < 4; ++ks) { const bf16x8 a = *(const LAS bf16x8*)(KT + srow * QLD + 32 * ks + 8 * kg); st[tau] = mfma16(a, qf[ks], st[tau]); } }
#pragma unroll
    for (int tau = 0; tau < 4; ++tau)
#pragma unroll
        for (int r = 0; r < 4; ++r) { const int s = 32 * (tau >> 1) + 8 * kg + 4 * (tau & 1) + r; if (s > tl) st[tau][r] = 0.f; }
    const bf16x8 pb0 = pack_p(st[0], st[1]), pb1 = pack_p(st[2], st[3]);
    f32x4 o[4];
#pragma unroll
    for (int vt = 0; vt < 4; ++vt) { o[vt] = (f32x4){0.f, 0.f, 0.f, 0.f}; const int vrow = 64 * vh + 16 * vt + tq;
        const bf16x8 i0 = *(const LAS bf16x8*)(IT + vrow * TLD + 8 * kg), i1 = *(const LAS bf16x8*)(IT + vrow * TLD + 32 + 8 * kg);
        o[vt] = mfma16(i0, pb0, o[vt]); o[vt] = mfma16(i1, pb1, o[vt]);
#pragma unroll
        for (int ks = 0; ks < 4; ++ks) o[vt] = mfma16(sf[vt][ks], qf[ks], o[vt]); }
    float ss = 0.f;
#pragma unroll
    for (int vt = 0; vt < 4; ++vt) ss += (o[vt][0] * o[vt][0] + o[vt][1] * o[vt][1]) + (o[vt][2] * o[vt][2] + o[vt][3] * o[vt][3]);
    ss = xrow16_sum(ss);
    if (kg == 0) GN[vh * 64 + tl] = ss;
    BAR_LDS();
    const float rn = rsqrtf((GN[tl] + GN[64 + tl]) * (1.f / 128.f) + EPS);
#pragma unroll
    for (int vt = 0; vt < 4; ++vt) { const int colv = h * 128 + 64 * vh + 16 * vt + 4 * kg;
        const f32x4 gwv = *(const f32x4*)(gw + colv);
        const float g0 = bflo(gg[vt].x), g1 = bfhi(gg[vt].x), g2 = bflo(gg[vt].y), g3 = bfhi(gg[vt].y);
        v2u ov; ov.x = pk2(o[vt][0] * rn * gwv.x * g0 * sigm(g0), o[vt][1] * rn * gwv.y * g1 * sigm(g1)); ov.y = pk2(o[vt][2] * rn * gwv.z * g2 * sigm(g2), o[vt][3] * rn * gwv.w * g3 * sigm(g3));
        *(v2u*)(MIXB + row * DM + colv) = ov; }
    BAR_LDS();
}
__device__ __forceinline__ void ph_prologue(LAS unsigned char* lds) {
    KA ka = fresh_args(); const int tid = fresh_tid(), lane = tid & 63, wave = tid >> 6;
    const int G = gridDim.x, bx = blockIdx.x, gw = bx * NWAVES + wave, NGW = G * NWAVES, gthread = bx * NTHREADS + tid, NTH = G * NTHREADS;
    bf16* W_EVIN = (bf16*)WSP(ka, WS_W_EVIN);
    LAS float* scr = (LAS float*)(lds + wave * 16640);
    const int n_evin = 32 * 73, n_sq = 32 * 32, n_odin = 32 * 128, n_gu = 32 * 176, n_dn = 88 * 32, n_c1 = 32 * 4;
    const int total = n_evin + n_sq + n_odin + n_sq + 2 * n_gu + 2 * n_dn + 2 * n_c1;
    for (int it = gw; it < total; it += NGW) {
        int r = it;
        if (r < n_evin) { tr_item(ka->in[I_EVWIN], DM, EV_REAL, W_EVIN, scr, r, lane, 1024, 2048, 2048, 3072, 0.125f); continue; } r -= n_evin;
        if (r < n_sq) { tr_item(ka->in[I_EVWOUT], DM, DM, (bf16*)WSP(ka, WS_W_EVOUT), scr, r, lane, 0, 0, 0, 0, 1.f); continue; } r -= n_sq;
        if (r < n_odin) { tr_item(ka->in[I_ODWIN], DM, OD_N, (bf16*)WSP(ka, WS_W_ODIN), scr, r, lane, 0, 0, 0, 0, 1.f); continue; } r -= n_odin;
        if (r < n_sq) { tr_item(ka->in[I_ODWOUT], DM, DM, (bf16*)WSP(ka, WS_W_ODOUT), scr, r, lane, 0, 0, 0, 0, 1.f); continue; } r -= n_sq;
        if (r < 2 * n_gu) { const int l = r / n_gu; tr_item(ka->in[I_WGU] + (size_t)l * DM * 2 * FF, DM, 2 * FF, (bf16*)WSP(ka, WS_W_GU) + (size_t)l * 2 * FF * DM, scr, r - l * n_gu, lane, FF, 2 * FF, 0, 0, 1.f); continue; } r -= 2 * n_gu;
        if (r < 2 * n_dn) { const int l = r / n_dn; tr_item(ka->in[I_WDN] + (size_t)l * FF * DM, FF, DM, (bf16*)WSP(ka, WS_W_DN) + (size_t)l * DM * FF, scr, r - l * n_dn, lane, 0, 0, 0, 0, 1.f); continue; } r -= 2 * n_dn;
        { const int l = r / n_c1; tr_item(ka->in[I_CW1] + (size_t)l * 2048 * 256, 2048, 256, (bf16*)WSP(ka, WS_W_C1) + (size_t)l * 256 * 2048, scr, r - l * n_c1, lane, 0, 0, 0, 0, 1.f); }
    }
    for (int i = gthread; i < (EV_N - EV_REAL) * DM / 8; i += NTH) *(v4u*)(W_EVIN + (size_t)EV_REAL * DM + (size_t)i * 8) = (v4u){0u, 0u, 0u, 0u};
    if (gw < 512) { const int wv = gw >> 8, cc = gw & 255; const float* pos = ka->in[I_CPOS] + wv * 2048; const float* w1 = ka->in[I_CW1] + (size_t)wv * 2048 * 256 + cc;
        float s = 0.f; for (int kx = lane; kx < 2048; kx += 64) s += pos[kx] * w1[(size_t)kx * 256];
        s = wave_sum(s); if (lane == 0) ((float*)WSP(ka, WS_SMALL))[gw] = s + ka->in[I_CB1][wv * 256 + cc]; }
    norm_rows(ka->in[I_X], ka->in[I_NORMW], (bf16*)WSP(ka, WS_HB), nullptr, gw, NGW, lane);
}
__device__ __forceinline__ void ph_norm(int which) {
    KA ka = fresh_args(); const int tid = fresh_tid(), lane = tid & 63, wave = tid >> 6;
    const int gw = blockIdx.x * NWAVES + wave, NGW = gridDim.x * NWAVES;
    const float* w = which == 0 ? ka->in[I_NORMW] + DM : which == 1 ? ka->in[I_NORMW] + 2 * DM : which == 2 ? ka->in[I_NORMW] + 3 * DM : ka->in[I_FNW];
    if (which == 3) norm_rows(ka->out, w, nullptr, ka->out, gw, NGW, lane);
    else norm_rows(ka->out, w, (bf16*)WSP(ka, WS_HB), nullptr, gw, NGW, lane);
}
__device__ __forceinline__ void ph_conv(LAS unsigned char* lds) {
    KA ka = fresh_args(); const int tid = fresh_tid();
    const int G = gridDim.x, bx = blockIdx.x, gthread = bx * NTHREADS + tid, NTH = G * NTHREADS;
    bf16* U2 = (bf16*)RP(ka, R_U2);
#ifndef SKIP_CONV
    for (int tile = bx; tile < T / 16; tile += G) conv_tile((const bf16*)RP(ka, R_HGLU), ka->in[I_CONVW], ka->in[I_CONVB], ka->in[I_LNW], ka->in[I_LNB], (bf16*)WSP(ka, WS_HB), lds, tile, tid);
#endif
    bf16* ACMP = (bf16*)RP(ka, R_ACMP);
    for (int ch0 = gthread; ch0 < 2 * 8192 * 256; ch0 += 8 * NTH) {
        v4u v[8];
#pragma unroll
        for (int q = 0; q < 8; ++q) { const int ch = ch0 + q * NTH;
            const int c8 = ch & 7, j = (ch >> 3) & 31, row = (ch >> 8) & 8191, wv = ch >> 21; const int n = row & 1023, bgx = row >> 10, b = bgx >> 2, g = bgx & 3;
            v[q] = (v4u){0u, 0u, 0u, 0u};
            if (ch < 2 * 8192 * 256 && n < 1023) v[q] = *(const v4u*)(U2 + ((size_t)b * SEQ + 16 * n + j) * U2_LD + (wv ? U2_VC : U2_KC) + g * 64 + c8 * 8); }
#pragma unroll
        for (int q = 0; q < 8; ++q) { const int ch = ch0 + q * NTH; if (ch < 2 * 8192 * 256) *(v4u*)(ACMP + (size_t)ch * 8) = v[q]; }
    }
    bf16* VST = (bf16*)RP(ka, R_VST); bf16* VWT = (bf16*)RP(ka, R_VWT);
    for (int ch0 = gthread; ch0 < 2 * NB * 4 * 64 * (SEQ / 8); ch0 += 4 * NTH) {
        unsigned e[4][8];
#pragma unroll
        for (int q = 0; q < 4; ++q) { const int ch = ch0 + q * NTH; const int d = ch & 63, s8 = (ch >> 6) & 2047, bgx = (ch >> 17) & 7, wv = (ch >> 20) & 1; const int b = bgx >> 2, g = bgx & 3;
            const bf16* src = U2 + ((size_t)b * SEQ + s8 * 8) * U2_LD + (wv ? U2_VW : U2_VS) + g * 64 + d;
#pragma unroll
            for (int i = 0; i < 8; ++i) e[q][i] = (ch < 2 * NB * 4 * 64 * (SEQ / 8)) ? src[(size_t)i * U2_LD] : 0u; }
#pragma unroll
        for (int q = 0; q < 4; ++q) { const int ch = ch0 + q * NTH; const int d = ch & 63, s8 = (ch >> 6) & 2047, bgx = (ch >> 17) & 7, wv = (ch >> 20) & 1;
            v4u v; v.x = e[q][0] | (e[q][1] << 16); v.y = e[q][2] | (e[q][3] << 16); v.z = e[q][4] | (e[q][5] << 16); v.w = e[q][6] | (e[q][7] << 16);
            if (ch < 2 * NB * 4 * 64 * (SEQ / 8)) *(v4u*)((wv ? VWT : VST) + ((size_t)bgx * 64 + d) * SEQ + s8 * 8) = v; }
    }
}
__device__ __forceinline__ void ph_cmp2() {
    KA ka = fresh_args(); const int tid = fresh_tid();
    const int gthread = blockIdx.x * NTHREADS + tid, NTH = gridDim.x * NTHREADS;
    const bf16* HID = (const bf16*)RP(ka, R_HID); bf16* KCMP = (bf16*)RP(ka, R_KCMP); bf16* VCMPT = (bf16*)RP(ka, R_VCMPT);
    for (int o = gthread; o < 2 * 8192 * 64; o += NTH) {
        const int d = o & 63, row = (o >> 6) & 8191, wv = o >> 19; const int n = row & 1023, bgx = row >> 10;
        float s = 0.f;
        if (n < 1023) { const bf16* hp = HID + ((size_t)wv * 8192 + row) * 256; const float* w2 = ka->in[I_CW2] + (size_t)wv * 256 * 64 + d;
            s = ka->in[I_CB2][wv * 64 + d];
#pragma unroll 8
            for (int k8 = 0; k8 < 32; ++k8) { const v4u hv = *(const v4u*)(hp + k8 * 8); const float* wp = w2 + (size_t)k8 * 8 * 64;
                s += bflo(hv.x) * wp[0] + bfhi(hv.x) * wp[64] + bflo(hv.y) * wp[128] + bfhi(hv.y) * wp[192] + bflo(hv.z) * wp[256] + bfhi(hv.z) * wp[320] + bflo(hv.w) * wp[384] + bfhi(hv.w) * wp[448]; } }
        if (wv == 0) KCMP[((size_t)bgx * 1024 + n) * 64 + d] = (bf16)f2bf(s); else VCMPT[((size_t)bgx * 64 + d) * 1024 + n] = (bf16)f2bf(s);
    }
}
__device__ __forceinline__ void ph_nsa(LAS unsigned char* lds) {
#ifndef SKIP_NSA
    const int tid = fresh_tid();
    const int G = gridDim.x, bx = blockIdx.x;
    const bool xm = (G & 7) == 0;
    const int nW = xm ? (G >> 3) : G, w0 = xm ? (bx >> 3) : bx, total = xm ? SEQ / 64 : 8 * (SEQ / 64);
#pragma unroll 1
    for (int u = w0, it = 0; u < total; u += nW, ++it) { const int bgx = xm ? ((bx + it) & 7) : u / (SEQ / 64), t64 = xm ? u : u % (SEQ / 64); nsa_block(lds, bgx >> 2, bgx & 3, t64 * 64, tid); }
#endif
}
__device__ __forceinline__ void ph_hgrnA(LAS unsigned char* lds) {
#ifndef SKIP_HGRN
    KA ka = fresh_args(); const int tid = fresh_tid();
    bf16* UB = (bf16*)RP(ka, R_UB);
    HTiles R; if ((int)blockIdx.x < 4096) hgrn_load_raw(R, UB, blockIdx.x, tid);
#pragma unroll 1
    for (int unit = blockIdx.x; unit < 4096; unit += gridDim.x) {
        HTiles Rc = R; const int nu = unit + gridDim.x;
        if (nu < 4096) hgrn_load_raw(R, UB, nu, tid);
        hgrn_passA(UB, ka->in[I_GAMMA], (bf16*)RP(ka, R_ZS), (float*)RP(ka, R_VEC), (bf16*)RP(ka, R_ITG), unit, Rc, lds, tid); }
#endif
}
__device__ __forceinline__ void ph_hgrnB() {
    KA ka = fresh_args(); const int tid = fresh_tid();
    hgrn_scan((bf16*)RP(ka, R_ZS), (const float*)RP(ka, R_VEC), blockIdx.x * NTHREADS + tid, gridDim.x * NTHREADS);
}
__device__ __forceinline__ void ph_hgrnC(LAS unsigned char* lds, int b) {
#ifndef SKIP_HGRN
    KA ka = fresh_args(); const int tid = fresh_tid();
    const bf16* UB = (const bf16*)RP(ka, R_UB); const bf16* ITG = (const bf16*)RP(ka, R_ITG);
    HTiles R; if ((int)blockIdx.x < 4096) hgrn_load_c(R, UB, ITG, blockIdx.x, tid);
#pragma unroll 1
    for (int unit = blockIdx.x; unit < 4096; unit += gridDim.x) { const int nu = unit + gridDim.x;
        hgrn_passC(UB, ITG, (const bf16*)RP(ka, R_ZS), ka->in[I_GNW], (bf16*)WSP(ka, WS_HB) + (size_t)b * SEQ * DM, unit, nu < 4096 ? nu : -1, R, lds, tid); }
#endif
}

template <int PHX> __device__ __forceinline__ void ph_gemm_resid(LAS unsigned char* lds) {
    KA ka = fresh_args(); const int G = gridDim.x, bx = blockIdx.x;
    const bf16* A = (PHX == 6 || PHX == 19) ? (const bf16*)WSP(ka, WS_HB) : (const bf16*)RP(ka, R_ACT);
    const bf16* Bw = PHX == 6 ? (const bf16*)WSP(ka, WS_W_EVOUT) : PHX == 19 ? (const bf16*)WSP(ka, WS_W_ODOUT) : (const bf16*)WSP(ka, WS_W_DN) + (PHX == 22 ? (size_t)DM * FF : 0);
    const int K = (PHX == 6 || PHX == 19) ? DM : FF;
    const float* base = PHX == 6 ? ka->in[I_X] : ka->out;
    pg8::Gemm g{A, Bw, T, DM, K}; pg8::StaticOrder S; S.init(T, DM, G, bx); pg8::EpiResid E{base, ka->out, DM};
    pg8::gemm_phase<pg8::EpiResid, pg8::StaticOrder, true, true>(lds, g, S, E);
}
template <int LAYER> __device__ __forceinline__ void ph_gemm_gu(LAS unsigned char* lds) {
    KA ka = fresh_args(); const int G = gridDim.x, bx = blockIdx.x;
    pg8::Gemm g{(const bf16*)WSP(ka, WS_HB), (const bf16*)WSP(ka, WS_W_GU) + (LAYER ? (size_t)2 * FF * DM : 0), T, 2 * FF, DM}; pg8::StaticOrder S; S.init(T, 2 * FF, G, bx); pg8::EpiSwiglu E{(bf16*)RP(ka, R_ACT), FF};
    pg8::gemm_phase<pg8::EpiSwiglu, pg8::StaticOrder, true, true>(lds, g, S, E);
}
template <int BT> __device__ __forceinline__ void ph_gemm_odin(LAS unsigned char* lds) {
    KA ka = fresh_args(); const int G = gridDim.x, bx = blockIdx.x;
    pg8::Gemm g{(const bf16*)WSP(ka, WS_HB) + (BT ? (size_t)SEQ * DM : 0), (const bf16*)WSP(ka, WS_W_ODIN), SEQ, OD_N, DM}; pg8::StaticOrder S; S.init(SEQ, OD_N, G, bx); pg8::EpiStore E{(bf16*)RP(ka, R_UB), OD_N, 0};
    pg8::gemm_phase<pg8::EpiStore, pg8::StaticOrder, true, true>(lds, g, S, E);
}
__device__ __forceinline__ void ph_gemm_evin(LAS unsigned char* lds) {
    KA ka = fresh_args(); const int G = gridDim.x, bx = blockIdx.x;
    pg8::Gemm g{(const bf16*)WSP(ka, WS_HB), (const bf16*)WSP(ka, WS_W_EVIN), T, EV_N, DM}; pg8::StaticOrder S; S.init(T, EV_N, G, bx); pg8::EpiEvenIn E{(bf16*)RP(ka, R_HGLU), (bf16*)RP(ka, R_U2), U2_LD};
    pg8::gemm_phase<pg8::EpiEvenIn, pg8::StaticOrder, true, true>(lds, g, S, E);
}
__device__ __forceinline__ void ph_gemm_cmp(LAS unsigned char* lds) {
    KA ka = fresh_args(); const int G = gridDim.x, bx = blockIdx.x;
    pg8::Gemm g{(const bf16*)RP(ka, R_ACMP), (const bf16*)WSP(ka, WS_W_C1), 16384, 256, DM}; pg8::CmpOrder S{G, bx}; pg8::EpiCmpHid E{(bf16*)RP(ka, R_HID), (const float*)WSP(ka, WS_SMALL)};
    pg8::gemm_phase<pg8::EpiCmpHid, pg8::CmpOrder, true, true>(lds, g, S, E);
}

__global__ void __launch_bounds__(NTHREADS, 2) mega_fwd(Args args) {
    extern __shared__ __attribute__((aligned(16))) unsigned char lds_raw[];
    LAS unsigned char* lds = (LAS unsigned char*)lds_raw;
    const int lo = args.ph_lo, hi = args.ph_hi;
    if (threadIdx.x < 16) ((LAS unsigned*)(lds + BAR_LDS_OFF))[threadIdx.x] = 0u;
    __syncthreads();
    if (blockIdx.x == 0) for (int i = threadIdx.x; i < XCD_BAR_WORDS; i += NTHREADS) ((unsigned*)(fresh_args()->ws + WS_BAR))[i] = 0u;
#define PH(k, body) if (lo <= (k) && (k) < hi) { body; if ((k) + 1 < hi) { if ((k) == 0) cg::this_grid().sync(); else grid_barrier(lds); } }
    PH(0, ph_prologue(lds))
    (void)xcd_barrier_post((unsigned*)(fresh_args()->ws + WS_BAR), (volatile LAS unsigned*)(lds + BAR_LDS_OFF));
    PH(1, ph_gemm_evin(lds))
    PH(2, ph_conv(lds))
    PH(3, ph_gemm_cmp(lds))
    PH(4, ph_cmp2())
    PH(5, ph_nsa(lds))
    PH(6, ph_gemm_resid<6>(lds))
    PH(7, ph_norm(0))
    PH(8, ph_gemm_gu<0>(lds))
    PH(9, ph_gemm_resid<9>(lds))
    PH(10, ph_norm(1))
    PH(11, ph_gemm_odin<0>(lds))
    PH(12, ph_hgrnA(lds))
    PH(13, ph_hgrnB())
    PH(14, ph_hgrnC(lds, 0))
    PH(15, ph_gemm_odin<1>(lds))
    PH(16, ph_hgrnA(lds))
    PH(17, ph_hgrnB())
    PH(18, ph_hgrnC(lds, 1))
    PH(19, ph_gemm_resid<19>(lds))
    PH(20, ph_norm(2))
    PH(21, ph_gemm_gu<1>(lds))
    PH(22, ph_gemm_resid<22>(lds))
    PH(23, ph_norm(3))
}
constexpr int N_PHASES = 24;

extern "C" void kernel_launch(void* const* d_in, const int* in_sizes, int n_in, void* d_out, int out_size, void* d_ws, size_t ws_size, hipStream_t stream) {
    static int grid = 0;
    if (grid == 0) {
        if (n_in != 20 || out_size != T * DM || ws_size < WS_END) { fprintf(stderr, "kernel_launch: unexpected shapes (n_in %d out %d ws %zu need %zu)\n", n_in, out_size, ws_size, (size_t)WS_END); grid = -1; return; }
        int dev = 0, cus = 0, per_cu = 0;
        (void)hipGetDevice(&dev); (void)hipDeviceGetAttribute(&cus, hipDeviceAttributeMultiprocessorCount, dev);
        (void)hipFuncSetAttribute((const void*)mega_fwd, hipFuncAttributeMaxDynamicSharedMemorySize, LDS_BYTES);
        (void)hipOccupancyMaxActiveBlocksPerMultiprocessor(&per_cu, (const void*)mega_fwd, NTHREADS, LDS_BYTES);
        if (per_cu < 1) per_cu = 1;
        (void)hipGetLastError();
        grid = cus * per_cu;
    }
    if (grid < 0) return;
    Args a{};
    for (int i = 0; i < 20; ++i) a.in[i] = (const float*)d_in[i];
    a.out = (float*)d_out; a.ws = (unsigned char*)d_ws;
#ifndef MK_PER_PHASE
    a.ph_lo = 0; a.ph_hi = N_PHASES;
    void* kargs[] = {&a};
    hipError_t e = hipLaunchCooperativeKernel((const void*)mega_fwd, dim3(grid), dim3(NTHREADS), kargs, LDS_BYTES, stream);
    if (e != hipSuccess) fprintf(stderr, "cooperative launch failed: %s (grid %d)\n", hipGetErrorString(e), grid);
#else
    for (int p = 0; p < N_PHASES; ++p) { a.ph_lo = p; a.ph_hi = p + 1; hipLaunchKernelGGL(mega_fwd, dim3(grid), dim3(NTHREADS), LDS_BYTES, stream, a); }
#endif
}
```

```cpp
#include <hip/hip_runtime.h>
#include <hip/hip_cooperative_groups.h>
#include <cstdio>
#include <cstdint>
namespace cg = cooperative_groups;
namespace pg8 {
#define PG8_LAS __attribute__((address_space(3)))
typedef unsigned short bf16_t;
typedef short bf16x8 __attribute__((ext_vector_type(8)));
typedef float f32x4 __attribute__((ext_vector_type(4)));
typedef unsigned u32x4 __attribute__((ext_vector_type(4)));
constexpr int BM = 256, BK = 64, HALF = 128, HTB = HALF * BK * 2  , STAGE_BYTES = 8 * HTB, NXCD = 8, WGM = 4;

__host__ __device__ __forceinline__ int lds_byte(int r, int c) { const int st = (r >> 4) * 2 + (c >> 5), rr = r & 15, cc = c & 31, ob = rr * 64 + cc * 2; return st * 1024 + (ob ^ (((ob >> 9) & 1) << 5)); }
__host__ __device__ __forceinline__ void stage_rc(int b, int& R, int& C) { const int st = b / 1024, sb = b % 1024, swz = sb ^ (((sb >> 9) & 1) << 5); R = (st >> 1) * 16 + swz / 64; C = (st & 1) * 32 + (swz % 64) / 2; }
__host__ __device__ __forceinline__ int perm32(int rho) { const int n = rho >> 4, i = rho & 15; return 8 * (i >> 2) + 4 * n + (i & 3); }

struct Unit { int pm, pn; };
struct Gemm { const bf16_t* A; const bf16_t* Bt; int M, N, K; };

struct StaticOrder {
    int nM, nN, nwg, G, c;
    __host__ __device__ void init(int M, int N, int G_, int c_) { nM = M / BM; nN = N / BM; nwg = nM * nN; G = G_; c = c_; }
    __host__ __device__ bool next(int i, Unit& u) const {
        const long L = (long)i * G + c; if (L >= nwg) return false;
        int wgid = (int)L; { const int q = nwg / NXCD, r = nwg % NXCD, xcd = wgid % NXCD, off = wgid / NXCD; wgid = (xcd < r ? xcd * (q + 1) : r * (q + 1) + (xcd - r) * q) + off; }
        const int nig = WGM * nN, gid = wgid / nig, fm = gid * WGM, gsz = (nM - fm) < WGM ? (nM - fm) : WGM;
        u.pm = fm + ((wgid % nig) % gsz); u.pn = (wgid % nig) / gsz; return true;
    }
    __device__ __forceinline__ void a_ready(const Unit&) const {}
    __device__ __forceinline__ void done(const Unit&) const {}
};

__device__ __forceinline__ unsigned cvt_pk_bf16(float lo, float hi) { unsigned r; asm volatile("v_cvt_pk_bf16_f32 %0, %1, %2" : "=v"(r) : "v"(lo), "v"(hi)); return r; }
__device__ __forceinline__ float sigmoidf_(float x) { return __builtin_amdgcn_rcpf(1.0f + __expf(-x)); }
struct EpiStore {
    static constexpr bool PERM = true, AFTER_DRAIN = false;
    bf16_t* O; int ldc; int pn0;
    __device__ __forceinline__ void operator()(const f32x4 (&acc)[2][2][4][2], const Unit& u, int wr, int wc, int fr, int fq) const {
        const int row0 = u.pm * BM + wr * 64 + fr; const int col0 = (u.pn - pn0) * BM + wc * 32 + 8 * fq;
#pragma unroll
        for (int ai = 0; ai < 2; ++ai)
#pragma unroll
            for (int m = 0; m < 4; ++m) { bf16_t* rowp = O + (size_t)(row0 + ai * HALF + m * 16) * ldc + col0;
#pragma unroll
                for (int bj = 0; bj < 2; ++bj) { const f32x4 v0 = acc[ai][bj][m][0], v1 = acc[ai][bj][m][1];
                    u32x4 w; w.x = cvt_pk_bf16(v0[0], v0[1]); w.y = cvt_pk_bf16(v0[2], v0[3]); w.z = cvt_pk_bf16(v1[0], v1[1]); w.w = cvt_pk_bf16(v1[2], v1[3]);
                    *(u32x4*)(rowp + bj * HALF) = w; } }
    }
};
template <int MODE> __device__ __forceinline__ void gated_store(const f32x4 (&acc)[2][2][4][2], const Unit& u, int wr, int wc, int fr, int fq, bf16_t* G, int ldg) {
    const int row0 = u.pm * BM + wr * 64 + fr; const int col0 = u.pn * HALF + wc * 32 + 8 * fq;
#pragma unroll
    for (int ai = 0; ai < 2; ++ai)
#pragma unroll
        for (int m = 0; m < 4; ++m) { bf16_t* rowp = G + (size_t)(row0 + ai * HALF + m * 16) * ldg + col0;
            float o[8];
#pragma unroll
            for (int n = 0; n < 2; ++n)
#pragma unroll
                for (int e = 0; e < 4; ++e) { const float a = acc[ai][0][m][n][e], b = acc[ai][1][m][n][e];
                    o[n * 4 + e] = (MODE == 0) ? a * sigmoidf_(b) : a * sigmoidf_(a) * b; }
            u32x4 w; w.x = cvt_pk_bf16(o[0], o[1]); w.y = cvt_pk_bf16(o[2], o[3]); w.z = cvt_pk_bf16(o[4], o[5]); w.w = cvt_pk_bf16(o[6], o[7]);
            *(u32x4*)rowp = w; }
}
struct EpiSwiglu {
    static constexpr bool PERM = true, AFTER_DRAIN = false;
    bf16_t* G; int ldg;
    __device__ __forceinline__ void operator()(const f32x4 (&acc)[2][2][4][2], const Unit& u, int wr, int wc, int fr, int fq) const { gated_store<1>(acc, u, wr, wc, fr, fq, G, ldg); }
};
struct EpiEvenIn {
    static constexpr bool PERM = true, AFTER_DRAIN = false;
    bf16_t* HG; bf16_t* U2; int ldu;
    __device__ __forceinline__ void operator()(const f32x4 (&acc)[2][2][4][2], const Unit& u, int wr, int wc, int fr, int fq) const {
        if (u.pn < 8) gated_store<0>(acc, u, wr, wc, fr, fq, HG, 1024);
        else { EpiStore E{U2, ldu, 8}; E(acc, u, wr, wc, fr, fq); }
    }
};
struct EpiResid {
    static constexpr bool PERM = false, AFTER_DRAIN = false;
    const float* base; float* out; int ldc;
    __device__ __forceinline__ void operator()(const f32x4 (&acc)[2][2][4][2], const Unit& u, int wr, int wc, int fr, int fq) const {
        const int col0 = u.pn * BM + wc * 32 + 4 * fq;
#pragma unroll
        for (int ai = 0; ai < 2; ++ai)
#pragma unroll
            for (int m = 0; m < 4; ++m) { const size_t off = (size_t)(u.pm * BM + ai * HALF + wr * 64 + m * 16 + fr) * ldc + col0;
#pragma unroll
                for (int bj = 0; bj < 2; ++bj)
#pragma unroll
                    for (int n = 0; n < 2; ++n) { const f32x4 bs = *(const f32x4*)(base + off + bj * HALF + n * 16); *(f32x4*)(out + off + bj * HALF + n * 16) = bs + acc[ai][bj][m][n]; } }
    }
};
struct EpiCmpHid {
    static constexpr bool PERM = true, AFTER_DRAIN = false;
    bf16_t* O; const float* bias;
    __device__ __forceinline__ void operator()(const f32x4 (&acc)[2][2][4][2], const Unit& u, int wr, int wc, int fr, int fq) const {
        const int row0 = u.pm * BM + wr * 64 + fr; const int col0 = wc * 32 + 8 * fq; const float* bb = bias + u.pn * 256;
#pragma unroll
        for (int ai = 0; ai < 2; ++ai)
#pragma unroll
            for (int m = 0; m < 4; ++m) { bf16_t* rowp = O + (size_t)(row0 + ai * HALF + m * 16) * 256 + col0;
#pragma unroll
                for (int bj = 0; bj < 2; ++bj) { float o[8];
#pragma unroll
                    for (int n = 0; n < 2; ++n)
#pragma unroll
                        for (int e = 0; e < 4; ++e) { const float v = acc[ai][bj][m][n][e] + bb[col0 + bj * HALF + n * 4 + e]; o[n * 4 + e] = v * sigmoidf_(v); }
                    u32x4 w; w.x = cvt_pk_bf16(o[0], o[1]); w.y = cvt_pk_bf16(o[2], o[3]); w.z = cvt_pk_bf16(o[4], o[5]); w.w = cvt_pk_bf16(o[6], o[7]);
                    *(u32x4*)(rowp + bj * HALF) = w; } }
    }
};
struct CmpOrder {
    int G, c;
    __device__ bool next(int i, Unit& u) const { const int L = i * G + c; if (L >= 64) return false; u.pm = L; u.pn = L >> 5; return true; }
    __device__ __forceinline__ void a_ready(const Unit&) const {}
    __device__ __forceinline__ void done(const Unit&) const {}
};
template <class Epi, class Sched, bool ALIGN_EPI = false, bool SP2 = false>
__device__ __forceinline__ void gemm_phase(PG8_LAS unsigned char* lds, const Gemm g, const Sched& S, const Epi& E) {
    const int tid = threadIdx.x, wid = __builtin_amdgcn_readfirstlane(tid >> 6), lane = tid & 63, wr = wid >> 2, wc = wid & 3, fr = lane & 15, fq = lane >> 4;
    const int K = g.K, nt = K / BK;
    unsigned voffA[2], voffB[2];
#pragma unroll
    for (int i = 0; i < 2; ++i) { int R, C; stage_rc(tid * 16 + i * 8192, R, C); const int Rb = Epi::PERM ? ((R & ~31) + perm32(R & 31)) : R;
        voffA[i] = (unsigned)(R * K + C) * 2u; voffB[i] = (unsigned)(Rb * K + C) * 2u; }
    const size_t kstep = (size_t)(BK * 2);
    const size_t hstep = (size_t)HALF * K * 2;
    const size_t tstep = 2 * hstep;
    const unsigned ldsw = (unsigned)wid * 1024u;
    const int aoff = lds_byte(wr * 64 + fr, fq * 8), boff = lds_byte(wc * 32 + fr, fq * 8);
#define PG8_SA(b, h) (((b) * 2 + (h)) * HTB)
#define PG8_SB(b, h) ((4 + (b) * 2 + (h)) * HTB)
#define PG8_STAGE(bufoff, gbase, voff) do { _Pragma("unroll") for (int _i = 0; _i < 2; ++_i) \
        __builtin_amdgcn_global_load_lds((const unsigned*)((const char*)(gbase) + (voff)[_i]), (PG8_LAS unsigned*)(lds + (bufoff) + ldsw + _i * 8192), 16, 0, 0); } while (0)
#define PG8_LDA(dst, b, h) do { _Pragma("unroll") for (int m = 0; m < 4; ++m) _Pragma("unroll") for (int k = 0; k < 2; ++k) dst[m][k] = *(const PG8_LAS bf16x8*)(lds + PG8_SA(b, h) + aoff + m * 2048 + k * 1024); } while (0)
#define PG8_LDB(dst, b, h) do { _Pragma("unroll") for (int n = 0; n < 2; ++n) _Pragma("unroll") for (int k = 0; k < 2; ++k) dst[n][k] = *(const PG8_LAS bf16x8*)(lds + PG8_SB(b, h) + boff + n * 2048 + k * 1024); } while (0)
#define PG8_MMA(ai, bj, At, Bt) do { __builtin_amdgcn_s_setprio(1); _Pragma("unroll") for (int m = 0; m < 4; ++m) _Pragma("unroll") for (int n = 0; n < 2; ++n) _Pragma("unroll") for (int k = 0; k < 2; ++k) \
        acc[ai][bj][m][n] = __builtin_amdgcn_mfma_f32_16x16x32_bf16(Bt[n][k], At[m][k], acc[ai][bj][m][n], 0, 0, 0); __builtin_amdgcn_s_setprio(0); } while (0)
#define PG8_WAIT_V(n) asm volatile("s_waitcnt vmcnt(" #n ")" ::: "memory")
#define PG8_WAIT_L(n) asm volatile("s_waitcnt lgkmcnt(" #n ")" ::: "memory")
#define PG8_BAR __builtin_amdgcn_s_barrier()
#define PG8_SCHED __builtin_amdgcn_sched_barrier(0)
    Unit cur, nxt; int ui = 0;
    if (!S.next(0, cur)) return;
    f32x4 acc[2][2][4][2];
#pragma unroll
    for (int a = 0; a < 2; ++a)
#pragma unroll
        for (int b = 0; b < 2; ++b)
#pragma unroll
            for (int m = 0; m < 4; ++m)
#pragma unroll
                for (int n = 0; n < 2; ++n) acc[a][b][m][n] = (f32x4){0.f, 0.f, 0.f, 0.f};
    bf16x8 At[4][2], B0[2][2], B1[2][2];
    const char* cA = (const char*)g.A + (size_t)cur.pm * tstep; const char* cB = (const char*)g.Bt + (size_t)cur.pn * tstep;
    S.a_ready(cur);
    if constexpr (SP2) {
        PG8_STAGE(PG8_SB(0, 0), cB, voffB); PG8_STAGE(PG8_SB(0, 1), cB + hstep, voffB); PG8_STAGE(PG8_SA(0, 0), cA, voffA); PG8_STAGE(PG8_SA(0, 1), cA + hstep, voffA);
        if (wr == 1) PG8_BAR;
        PG8_WAIT_V(2); PG8_BAR;
        PG8_STAGE(PG8_SB(1, 0), cB + kstep, voffB); PG8_STAGE(PG8_SA(1, 0), cA + kstep, voffA); PG8_STAGE(PG8_SB(1, 1), cB + hstep + kstep, voffB);
        PG8_WAIT_V(6); PG8_BAR;
    } else {
        PG8_STAGE(PG8_SB(0, 0), cB, voffB); PG8_STAGE(PG8_SA(0, 0), cA, voffA); PG8_STAGE(PG8_SB(0, 1), cB + hstep, voffB); PG8_STAGE(PG8_SA(0, 1), cA + hstep, voffA);
        if (wr == 1) PG8_BAR;
        PG8_WAIT_V(4); PG8_BAR;
        PG8_STAGE(PG8_SB(1, 0), cB + kstep, voffB); PG8_STAGE(PG8_SA(1, 0), cA + kstep, voffA); PG8_STAGE(PG8_SB(1, 1), cB + hstep + kstep, voffB);
        PG8_WAIT_V(6); PG8_BAR;
    }
    for (;;) {
        const bool has_next = S.next(ui + 1, nxt);
        const char* nA = has_next ? (const char*)g.A + (size_t)nxt.pm * tstep : cA; const char* nB = has_next ? (const char*)g.Bt + (size_t)nxt.pn * tstep : cB;
        for (int t = 0; t < nt; t += 2) {
            const bool last = (t == nt - 2);
            const char* a1 = cA + (size_t)(t + 1) * kstep;
            const char* a2 = last ? nA : cA + (size_t)(t + 2) * kstep; const char* b2 = last ? nB : cB + (size_t)(t + 2) * kstep;
            const char* a3 = a2 + kstep; const char* b3 = b2 + kstep;
            if (last && has_next) S.a_ready(nxt);
            if constexpr (SP2) {
            PG8_LDB(B0, 0, 0); PG8_LDB(B1, 0, 1); PG8_SCHED; PG8_LDA(At, 0, 0); PG8_STAGE(PG8_SA(1, 1), a1 + hstep, voffA);
            PG8_WAIT_V(8); PG8_WAIT_L(0); PG8_BAR; PG8_MMA(0, 0, At, B0); PG8_MMA(0, 1, At, B1); PG8_BAR; PG8_SCHED;
            PG8_LDA(At, 0, 1); PG8_STAGE(PG8_SB(0, 0), b2, voffB); PG8_STAGE(PG8_SB(0, 1), b2 + hstep, voffB); PG8_STAGE(PG8_SA(0, 0), a2, voffA);
            PG8_WAIT_V(8); PG8_WAIT_L(0); PG8_BAR; PG8_MMA(1, 0, At, B0); PG8_MMA(1, 1, At, B1); PG8_BAR; PG8_SCHED;
            PG8_LDB(B0, 1, 0); PG8_LDB(B1, 1, 1); PG8_SCHED; PG8_LDA(At, 1, 0); PG8_STAGE(PG8_SA(0, 1), a2 + hstep, voffA);
            PG8_WAIT_V(8); PG8_WAIT_L(0); PG8_BAR; PG8_MMA(0, 0, At, B0); PG8_MMA(0, 1, At, B1); PG8_BAR; PG8_SCHED;
            PG8_LDA(At, 1, 1); PG8_STAGE(PG8_SB(1, 0), b3, voffB); PG8_STAGE(PG8_SB(1, 1), b3 + hstep, voffB); PG8_STAGE(PG8_SA(1, 0), a3, voffA);
            PG8_WAIT_V(8); PG8_WAIT_L(0); PG8_BAR; PG8_MMA(1, 0, At, B0); PG8_MMA(1, 1, At, B1); PG8_BAR; PG8_SCHED;
            } else {
            PG8_LDB(B0, 0, 0); PG8_SCHED; PG8_LDA(At, 0, 0); PG8_STAGE(PG8_SA(1, 1), a1 + hstep, voffA);
            PG8_WAIT_L(8); PG8_BAR; PG8_WAIT_L(0); PG8_MMA(0, 0, At, B0); PG8_BAR; PG8_SCHED;
            PG8_LDB(B1, 0, 1); PG8_STAGE(PG8_SB(0, 0), b2, voffB);
            PG8_BAR; PG8_WAIT_L(0); PG8_MMA(0, 1, At, B1); PG8_BAR;
            PG8_LDA(At, 0, 1); PG8_STAGE(PG8_SA(0, 0), a2, voffA);
            PG8_BAR; PG8_WAIT_L(0); PG8_MMA(1, 0, At, B0); PG8_BAR; PG8_SCHED;
            PG8_STAGE(PG8_SB(0, 1), b2 + hstep, voffB);
            PG8_WAIT_V(6); PG8_BAR; PG8_MMA(1, 1, At, B1); PG8_BAR;
            PG8_LDB(B0, 1, 0); PG8_SCHED; PG8_LDA(At, 1, 0); PG8_STAGE(PG8_SA(0, 1), a2 + hstep, voffA);
            PG8_WAIT_L(8); PG8_BAR; PG8_WAIT_L(0); PG8_MMA(0, 0, At, B0); PG8_BAR; PG8_SCHED;
            PG8_LDB(B1, 1, 1); PG8_STAGE(PG8_SB(1, 0), b3, voffB);
            PG8_BAR; PG8_WAIT_L(0); PG8_MMA(0, 1, At, B1); PG8_BAR;
            PG8_LDA(At, 1, 1); PG8_STAGE(PG8_SA(1, 0), a3, voffA);
            PG8_BAR; PG8_WAIT_L(0); PG8_MMA(1, 0, At, B0); PG8_BAR; PG8_SCHED;
            PG8_STAGE(PG8_SB(1, 1), b3 + hstep, voffB);
            PG8_WAIT_V(6); PG8_BAR; PG8_MMA(1, 1, At, B1); PG8_BAR;
            }
        }
        if constexpr (ALIGN_EPI) { if (wr == 0) PG8_BAR; }
        if constexpr (!Epi::AFTER_DRAIN) { E(acc, cur, wr, wc, fr, fq); S.done(cur); }
        if (!has_next) break;
#pragma unroll
        for (int a = 0; a < 2; ++a)
#pragma unroll
            for (int b = 0; b < 2; ++b)
#pragma unroll
                for (int m = 0; m < 4; ++m)
#pragma unroll
                    for (int n = 0; n < 2; ++n) acc[a][b][m][n] = (f32x4){0.f, 0.f, 0.f, 0.f};
        cur = nxt; cA = nA; cB = nB; ++ui;
        if constexpr (ALIGN_EPI) { if (wr == 1) PG8_BAR; }
    }
    PG8_WAIT_V(0);
    if constexpr (!ALIGN_EPI) { if (wr == 0) PG8_BAR; }
    PG8_BAR;
    if constexpr (Epi::AFTER_DRAIN) { E.fused(acc, cur, wr, wc, fr, fq, lds, wid, lane); S.done(cur); }
#undef PG8_SA
#undef PG8_SB
#undef PG8_STAGE
#undef PG8_LDA
#undef PG8_LDB
#undef PG8_MMA
#undef PG8_WAIT_V
#undef PG8_WAIT_L
#undef PG8_BAR
#undef PG8_SCHED
}
}

#define LAS __attribute__((address_space(3)))
typedef unsigned short bf16;
typedef float f32x4 __attribute__((ext_vector_type(4)));
typedef short bf16x8 __attribute__((ext_vector_type(8)));
typedef unsigned v4u __attribute__((ext_vector_type(4)));
typedef unsigned v2u __attribute__((ext_vector_type(2)));
typedef unsigned long long u64;
typedef float f32x2 __attribute__((ext_vector_type(2)));
constexpr int NB = 2, SEQ = 16384, T = NB * SEQ, DM = 2048, FF = 5632;
constexpr int EV_REAL = 4656, EV_N = 4864, U2_LD = 2816;
constexpr int U2_Q = 0, U2_KC = 1024, U2_VC = 1280, U2_KS = 1536, U2_VS = 1792, U2_KW = 2048, U2_VW = 2304, U2_G = 2560;
constexpr int OD_N = 8192;
constexpr float EPS = 1e-6f, TINYF = 1e-30f;
constexpr size_t MiB = 1u << 20;
constexpr size_t WS_BAR = 0;
constexpr size_t WS_SMALL = 65536;
constexpr size_t WS_W_EVIN = 1 * MiB, WS_W_EVOUT = 20 * MiB, WS_W_ODIN = 28 * MiB, WS_W_ODOUT = 60 * MiB, WS_W_GU = 68 * MiB, WS_W_DN = 156 * MiB, WS_W_C1 = 200 * MiB;
constexpr size_t WS_HB = 204 * MiB;
constexpr size_t WS_R = 332 * MiB;
constexpr size_t R_HGLU = 0, R_U2 = 64 * MiB, R_ACMP = 240 * MiB, R_HID = 304 * MiB, R_KCMP = 312 * MiB, R_VCMPT = 313 * MiB, R_VST = 314 * MiB, R_VWT = 330 * MiB;
constexpr size_t R_ACT = 0;
constexpr size_t R_UB = 0, R_ZS = 256 * MiB, R_VEC = 384 * MiB, R_ITG = 388 * MiB;
constexpr size_t WS_END = WS_R + 452 * MiB;
constexpr int NWAVES = 8, NTHREADS = 512;
constexpr int LDS_BYTES = 147456;

__device__ __forceinline__ unsigned pk2(float lo, float hi) { return pg8::cvt_pk_bf16(lo, hi); }
__device__ __forceinline__ unsigned f2bf(float f) { return pg8::cvt_pk_bf16(f, 0.f) & 0xffffu; }
__device__ __forceinline__ float bf2f(unsigned h) { return __builtin_bit_cast(float, h << 16); }
__device__ __forceinline__ float bflo(unsigned w) { return __builtin_bit_cast(float, w << 16); }
__device__ __forceinline__ float bfhi(unsigned w) { return __builtin_bit_cast(float, w & 0xffff0000u); }
__device__ __forceinline__ float sigm(float x) { return __builtin_amdgcn_rcpf(1.0f + __expf(-x)); }
#define LDS_WAIT() asm volatile("s_waitcnt lgkmcnt(0)" ::: "memory")
__device__ __forceinline__ f32x4 mfma16(bf16x8 a, bf16x8 b, f32x4 c) { return __builtin_amdgcn_mfma_f32_16x16x32_bf16(a, b, c, 0, 0, 0); }

struct Args { const float* in[20]; float* out; unsigned char* ws; int ph_lo, ph_hi; };
enum { I_X = 0, I_NORMW, I_FNW, I_EVWIN, I_CONVW, I_CONVB, I_LNW, I_LNB, I_CPOS, I_CW1, I_CB1, I_CW2, I_CB2, I_EVWOUT, I_ODWIN, I_GAMMA, I_GNW, I_ODWOUT, I_WGU, I_WDN };

typedef const __attribute__((address_space(4))) Args* KA;
__device__ __forceinline__ int fresh_tid() { int t = threadIdx.x; asm volatile("" : "+v"(t)); return t; }
__device__ __forceinline__ KA fresh_args() { KA p = (KA)__builtin_amdgcn_kernarg_segment_ptr(); asm volatile("" : "+s"(p)); return p; }
#define WSP(ka, off) ((ka)->ws + (off))
#define RP(ka, off) ((ka)->ws + WS_R + (off))


#define XB_TMO      128
#define XB_XCNT(j)  (256  + 64 * (j))
#define XB_XSUB(j)  (1280 + 64 * (j))
#define XB_XGEN(j)  (2304 + 64 * (j))
#define XB_TOP      3328
#define XB_TOPGEN   3392
#define XCD_BAR_WORDS 3456
#define XB_SPIN_CAP (1u << 18)

__device__ __forceinline__ unsigned xb_ld(unsigned* p)              { return __hip_atomic_load(p, __ATOMIC_RELAXED, __HIP_MEMORY_SCOPE_AGENT); }
__device__ __forceinline__ unsigned xb_add(unsigned* p, unsigned v) { return __hip_atomic_fetch_add(p, v, __ATOMIC_RELAXED, __HIP_MEMORY_SCOPE_AGENT); }
__device__ __forceinline__ unsigned xb_xcc_id() { return (unsigned)__builtin_amdgcn_s_getreg((3 << 11) | 20) & 0xFu; }
#define XB_SPIN(cond, bar) do { unsigned _sp = 0; while (cond) { __builtin_amdgcn_s_sleep(1); \
    if ((++_sp & 255u) == 0u) { if (xb_ld(&(bar)[XB_TMO])) break; if (_sp > XB_SPIN_CAP) { atomicAdd(&(bar)[XB_TMO], 1u); break; } } } } while (0)

struct XcdBarrier {
    unsigned* bar; unsigned x;
    volatile LAS unsigned* st;
};

__device__ __forceinline__ XcdBarrier xcd_barrier_post(unsigned* bar, volatile LAS unsigned* st) {
    XcdBarrier b; b.bar = bar; b.x = xb_xcc_id(); b.st = st;
    if (threadIdx.x == 0) (void)xb_add(&bar[XB_XCNT(b.x)], 1u);
    return b;
}
__device__ __forceinline__ void xcd_barrier_complete(unsigned* bar, unsigned x, unsigned& nloc, unsigned& nx) {
    const unsigned G = gridDim.x * gridDim.y * gridDim.z;
    unsigned sum, cnt, mine, sp = 0u;
    for (;;) {
        sum = 0u; cnt = 0u; mine = 0u;
#pragma unroll
        for (unsigned j = 0; j < 16; ++j) { const unsigned c = xb_ld(&bar[XB_XCNT(j)]); sum += c; cnt += (c > 0u) ? 1u : 0u; mine = (j == x) ? c : mine; }
        if (sum == G) break;
        __builtin_amdgcn_s_sleep(1);
        if ((++sp & 255u) == 0u) { if (xb_ld(&bar[XB_TMO])) break; if (sp > XB_SPIN_CAP) { atomicAdd(&bar[XB_TMO], 1u); break; } }
    }
    nloc = mine > 0u ? mine : 1u; nx = cnt > 0u ? cnt : 1u;
}

__device__ __forceinline__ void xcd_barrier(const XcdBarrier& b) {
    asm volatile("s_waitcnt vmcnt(0)" ::: "memory");
    __syncthreads();
    if (threadIdx.x == 0) {
        unsigned* bar = b.bar;
        __builtin_amdgcn_s_waitcnt(0);
        unsigned nloc = b.st[0], nx = b.st[1];
        if (nloc == 0u) { xcd_barrier_complete(bar, b.x, nloc, nx); b.st[0] = nloc; b.st[1] = nx; }
        const unsigned old = xb_add(&bar[XB_XSUB(b.x)], 1u);
        const unsigned gen = old / nloc;
        if (old + 1u == (gen + 1u) * nloc) {
            __builtin_amdgcn_fence(__ATOMIC_RELEASE, "agent");
            asm volatile("s_waitcnt vmcnt(0)" ::: "memory");
            const unsigned og = xb_add(&bar[XB_TOP], 1u);
            const unsigned tg = og / nx;
            if (og + 1u == (tg + 1u) * nx) xb_add(&bar[XB_TOPGEN], 1u);
            else XB_SPIN(xb_ld(&bar[XB_TOPGEN]) == tg, bar);
            __builtin_amdgcn_fence(__ATOMIC_ACQUIRE, "agent");
            xb_add(&bar[XB_XGEN(b.x)], 1u);
            asm volatile("s_waitcnt vmcnt(0)" ::: "memory");
        } else {
            XB_SPIN(xb_ld(&bar[XB_XGEN(b.x)]) == gen, bar);
            __builtin_amdgcn_fence(__ATOMIC_ACQUIRE, "agent");
            asm volatile("s_waitcnt vmcnt(0)" ::: "memory");
        }
    }
    __syncthreads();
}

constexpr int BAR_LDS_OFF = LDS_BYTES - 64;
__device__ __forceinline__ void grid_barrier(LAS unsigned char* lds) {
    XcdBarrier b; b.bar = (unsigned*)(fresh_args()->ws + WS_BAR); b.x = xb_xcc_id(); b.st = (volatile LAS unsigned*)(lds + BAR_LDS_OFF);
    xcd_barrier(b);
}

__device__ __forceinline__ int dest_row(int n, int half, int inter_end) {
    if (n < inter_end) { const int hf = n >= half ? 1 : 0; const int np = n - hf * half; return ((np >> 7) << 8) + hf * 128 + (np & 127); }
    return n;
}
__device__ __forceinline__ void tr_item(const float* W, int K, int N, bf16* WT, LAS float* scr, int item, int lane, int half, int inter_end, int sc_from, int sc_to, float sc) {
    const int nblk = (N + 63) / 64, kb = item / nblk, nb = item % nblk, k0 = 64 * kb, n0 = 64 * nb;
    const int ncol = n0 + lane; const bool okc = ncol < N;
    float wreg[64];
#pragma unroll
    for (int kk = 0; kk < 64; ++kk) wreg[kk] = okc ? W[(size_t)(k0 + kk) * N + ncol] : 0.f;
#pragma unroll
    for (int kk = 0; kk < 64; ++kk) scr[kk * 65 + lane] = wreg[kk];
    LDS_WAIT();
    const int c = lane & 7;
#pragma unroll
    for (int j = 0; j < 8; ++j) { const int n = (lane >> 3) + 8 * j; const LAS float* sp = scr + (8 * c) * 65 + n;
        const int nn = n0 + n; const float s = (nn >= sc_from && nn < sc_to) ? sc : 1.f;
        v4u o; o.x = pk2(sp[0 * 65] * s, sp[1 * 65] * s); o.y = pk2(sp[2 * 65] * s, sp[3 * 65] * s); o.z = pk2(sp[4 * 65] * s, sp[5 * 65] * s); o.w = pk2(sp[6 * 65] * s, sp[7 * 65] * s);
        *(v4u*)(WT + (size_t)dest_row(nn, half, inter_end) * K + k0 + 8 * c) = o; }
    LDS_WAIT();
}
__device__ __forceinline__ float wave_sum(float v) {
#pragma unroll
    for (int o = 1; o < 64; o <<= 1) v += __shfl_xor(v, o);
    return v;
}
__device__ __forceinline__ void norm_rows(const float* x, const float* w, bf16* outb, float* outf, int gw, int ngw, int lane) {
    f32x4 wv[8];
#pragma unroll
    for (int j = 0; j < 8; ++j) wv[j] = *(const f32x4*)(w + 4 * (lane + 64 * j));
    for (int m = gw; m < T; m += ngw) {
        const f32x4* xr = (const f32x4*)(x + (size_t)m * DM) + lane;
        f32x4 v[8]; float s = 0.f;
#pragma unroll
        for (int j = 0; j < 8; ++j) { v[j] = xr[64 * j]; s += (v[j].x * v[j].x + v[j].y * v[j].y) + (v[j].z * v[j].z + v[j].w * v[j].w); }
        const float rstd = rsqrtf(wave_sum(s) * (1.f / DM) + EPS);
        if (outb) { v2u* o8 = (v2u*)(outb + (size_t)m * DM) + lane;
#pragma unroll
            for (int j = 0; j < 8; ++j) { v2u o; o.x = pk2(v[j].x * rstd * wv[j].x, v[j].y * rstd * wv[j].y); o.y = pk2(v[j].z * rstd * wv[j].z, v[j].w * rstd * wv[j].w); o8[64 * j] = o; } }
        else { f32x4* of = (f32x4*)(outf + (size_t)m * DM) + lane;
#pragma unroll
            for (int j = 0; j < 8; ++j) of[64 * j] = v[j] * rstd * wv[j]; }
    }
}

__device__ __forceinline__ void conv_tile(const bf16* HG, const float* cw, const float* cb, const float* lnw, const float* lnb, bf16* MIX, LAS unsigned char* lds, int tile, int tid) {
    const int lane = tid & 63, wave = tid >> 6;
    const int row0 = tile * 16;
    const int pos0 = row0 & (SEQ - 1);
    const int c0 = tid * 2;
    float w0[31], w1[31];
#pragma unroll
    for (int j = 0; j < 31; ++j) { const f32x2 wv = *(const f32x2*)(cw + j * 1024 + c0); w0[j] = wv.x; w1[j] = wv.y; }
    float a0[16], a1[16];
    const f32x2 bv = *(const f32x2*)(cb + c0);
#pragma unroll
    for (int i = 0; i < 16; ++i) { a0[i] = bv.x; a1[i] = bv.y; }
#pragma unroll
    for (int ri = 0; ri < 46; ++ri) {
        const int p = pos0 - 30 + ri;
        unsigned xw = 0u;
        if (p >= 0) xw = *(const unsigned*)(HG + (size_t)(row0 - 30 + ri) * 1024 + c0);
        const float x0 = bflo(xw), x1 = bfhi(xw);
#pragma unroll
        for (int to = 0; to < 16; ++to) { const int j = ri - to; if (j >= 0 && j <= 30) { a0[to] += w0[j] * x0; a1[to] += w1[j] * x1; } }
    }
    LAS float* tl = (LAS float*)lds;
#pragma unroll
    for (int to = 0; to < 16; ++to) { f32x2 pv2; pv2.x = a0[to]; pv2.y = a1[to]; *(LAS f32x2*)(tl + to * 1024 + c0) = pv2; }
    __syncthreads();
#pragma unroll 1
    for (int q = 0; q < 2; ++q) { const int to = wave * 2 + q; const LAS f32x4* rp = (const LAS f32x4*)(tl + to * 1024) + lane;
        f32x4 v[4]; float s = 0.f;
#pragma unroll
        for (int j = 0; j < 4; ++j) { v[j] = rp[64 * j]; s += (v[j].x + v[j].y) + (v[j].z + v[j].w); }
        const float mu = wave_sum(s) * (1.f / 1024.f); float s2 = 0.f;
#pragma unroll
        for (int j = 0; j < 4; ++j) { v[j] = v[j] - mu; s2 += (v[j].x * v[j].x + v[j].y * v[j].y) + (v[j].z * v[j].z + v[j].w * v[j].w); }
        const float rstd = rsqrtf(wave_sum(s2) * (1.f / 1024.f) + EPS);
        v2u* op = (v2u*)(MIX + (size_t)(row0 + to) * DM) + lane;
#pragma unroll
        for (int j = 0; j < 4; ++j) { const f32x4 lw = *(const f32x4*)(lnw + 4 * (lane + 64 * j)), lb = *(const f32x4*)(lnb + 4 * (lane + 64 * j));
            f32x4 h = v[j] * rstd * lw + lb; h.x = h.x * sigm(h.x); h.y = h.y * sigm(h.y); h.z = h.z * sigm(h.z); h.w = h.w * sigm(h.w);
            v2u o; o.x = pk2(h.x, h.y); o.y = pk2(h.z, h.w); op[64 * j] = o; } }
    __syncthreads();
}

#define BAR_LDS() do { asm volatile("s_waitcnt lgkmcnt(0)" ::: "memory"); __builtin_amdgcn_s_barrier(); asm volatile("" ::: "memory"); } while (0)
__device__ __forceinline__ bf16x8 pack_p(const f32x4& a, const f32x4& b) {
    v4u w; w.x = pg8::cvt_pk_bf16(a[0], a[1]); w.y = pg8::cvt_pk_bf16(a[2], a[3]); w.z = pg8::cvt_pk_bf16(b[0], b[1]); w.w = pg8::cvt_pk_bf16(b[2], b[3]);
    return __builtin_bit_cast(bf16x8, w);
}
constexpr float LOG2E = 1.4426950408889634f;
template <int CTRL> __device__ __forceinline__ float dppf(float x) { return __builtin_bit_cast(float, __builtin_amdgcn_mov_dpp(__builtin_bit_cast(int, x), CTRL, 0xf, 0xf, true)); }
constexpr int DPP_XOR1 = 0xB1, DPP_XOR2 = 0x4E;
__device__ __forceinline__ float xrow16_max(float x) {
    auto s = __builtin_amdgcn_permlane16_swap(__float_as_uint(x), __float_as_uint(x), false, false);
    x = fmaxf(__uint_as_float(s[0]), __uint_as_float(s[1]));
    auto t = __builtin_amdgcn_permlane32_swap(__float_as_uint(x), __float_as_uint(x), false, false);
    return fmaxf(__uint_as_float(t[0]), __uint_as_float(t[1]));
}
template <int CTRL> __device__ __forceinline__ unsigned dppu(unsigned x) { return (unsigned)__builtin_amdgcn_mov_dpp((int)x, CTRL, 0xf, 0xf, true); }
__device__ __forceinline__ unsigned wave_max_u32(unsigned x) {
    x = max(x, dppu<0xB1>(x)); x = max(x, dppu<0x4E>(x)); x = max(x, dppu<0x141>(x)); x = max(x, dppu<0x140>(x));
    auto s = __builtin_amdgcn_permlane16_swap(x, x, false, false); x = max((unsigned)s[0], (unsigned)s[1]);
    auto t = __builtin_amdgcn_permlane32_swap(x, x, false, false); return max((unsigned)t[0], (unsigned)t[1]);
}
__device__ __forceinline__ float xrow16_sum(float x) {
    auto s = __builtin_amdgcn_permlane16_swap(__float_as_uint(x), __float_as_uint(x), false, false);
    x = __uint_as_float(s[0]) + __uint_as_float(s[1]);
    auto t = __builtin_amdgcn_permlane32_swap(__float_as_uint(x), __float_as_uint(x), false, false);
    return __uint_as_float(t[0]) + __uint_as_float(t[1]);
}
constexpr int KT_LD = 72;
constexpr int NSA_WSTRIDE = 8448, NSA_TILE0 = 8 * NSA_WSTRIDE, NSA_TILE_STRIDE = 18432, NSA_V_OFF = 9216, NSA_XCH = NSA_TILE0 + 2 * NSA_TILE_STRIDE;
__device__ __forceinline__ int pop_bit(u64& u0, u64& u1, u64& u2, u64& u3) {
    if (u0) { const int j = __builtin_ctzll(u0); u0 &= u0 - 1; return j; }
    if (u1) { const int j = __builtin_ctzll(u1); u1 &= u1 - 1; return 64 + j; }
    if (u2) { const int j = __builtin_ctzll(u2); u2 &= u2 - 1; return 128 + j; }
    if (u3) { const int j = __builtin_ctzll(u3); u3 &= u3 - 1; return 192 + j; }
    return -1;
}
template <int MODE>
__device__ __forceinline__ void nsa_soft(f32x4 (&st)[4], const float (&Bl)[16], float cl, bool fast, int keybase, int t, bool sel, float& m2, float& l, f32x4 (&o)[4], float lfin, LAS float* imp, int lane) {
    const int kg = lane >> 4;
#pragma unroll
    for (int tau = 0; tau < 4; ++tau)
#pragma unroll
        for (int r = 0; r < 4; ++r) st[tau][r] = __builtin_fmaf(st[tau][r], LOG2E, Bl[tau * 4 + r]);
    if (!fast) {
#pragma unroll
        for (int tau = 0; tau < 4; ++tau)
#pragma unroll
            for (int r = 0; r < 4; ++r) { const int off = keybase + 32 * (tau >> 1) + 8 * kg + 4 * (tau & 1) + r;
                int dist; bool valid;
                if (MODE <= 1) { dist = t - (16 * off + 31); valid = dist >= 0; }
                else if (MODE == 2) { dist = t - off; valid = sel && dist >= 0; }
                else { dist = t - off; valid = dist >= 0 && dist < 512; }
                st[tau][r] = valid ? st[tau][r] : -INFINITY; }
    }
    if (MODE == 1) {
        const float sh = cl - lfin;
#pragma unroll
        for (int tau = 0; tau < 4; ++tau) {
#pragma unroll
            for (int r = 0; r < 4; ++r) st[tau][r] = __builtin_amdgcn_exp2f(st[tau][r] + sh);
            float ps = (st[tau][0] + st[tau][1]) + (st[tau][2] + st[tau][3]), p3 = st[tau][3];
            ps += dppf<DPP_XOR1>(ps); ps += dppf<DPP_XOR2>(ps); p3 += dppf<DPP_XOR1>(p3); p3 += dppf<DPP_XOR2>(p3);
            const int j0 = (keybase >> 2) + 8 * (tau >> 1) + 2 * kg + (tau & 1);
            if ((lane & 3) == 0) { const int tk = (lane & 15) >> 2; imp[tk * 256 + j0] += ps; if (j0 + 1 < 256) imp[tk * 256 + j0 + 1] += p3; }
        }
    } else {
        float mloc = fmaxf(fmaxf(fmaxf(st[0][0], st[0][1]), fmaxf(st[0][2], st[0][3])), fmaxf(fmaxf(st[1][0], st[1][1]), fmaxf(st[1][2], st[1][3])));
        mloc = fmaxf(mloc, fmaxf(fmaxf(fmaxf(st[2][0], st[2][1]), fmaxf(st[2][2], st[2][3])), fmaxf(fmaxf(st[3][0], st[3][1]), fmaxf(st[3][2], st[3][3]))));
        mloc = xrow16_max(mloc);
        const float mnew = fmaxf(m2, mloc + cl); const float alpha = __builtin_amdgcn_exp2f(m2 - mnew); m2 = mnew;
        const float sh = cl - mnew;
        float ps = 0.f;
#pragma unroll
        for (int tau = 0; tau < 4; ++tau)
#pragma unroll
            for (int r = 0; r < 4; ++r) { const float p = __builtin_amdgcn_exp2f(st[tau][r] + sh); st[tau][r] = p; ps += p; }
        l = l * alpha + ps;
        if (MODE != 0) {
#pragma unroll
            for (int dt = 0; dt < 4; ++dt) o[dt] = o[dt] * alpha;
        }
    }
}
template <int MODE>
__device__ __forceinline__ void attn_step2(const LAS bf16* kt, const LAS bf16* vt, const bf16x8 (&qf)[2][2], const float (&Bl)[16], const float (&cl)[2], bool fast, int keybase, const int (&t)[2], const bool (&sel)[2],
                                           float (&m2)[2], float (&l)[2], f32x4 (&o)[2][4], const float (&lfin)[2], LAS float* imp, int lane) {
    const int kg = lane >> 4;
    f32x4 st[2][4];
    { const int rho = lane & 15, dof = kg * 8;
#pragma unroll
      for (int tau = 0; tau < 4; ++tau) { const LAS bf16* rp = kt + (16 * tau + rho) * KT_LD + dof;
          const bf16x8 k0 = *(const LAS bf16x8*)(rp), k1 = *(const LAS bf16x8*)(rp + 32);
#pragma unroll
          for (int s = 0; s < 2; ++s) { st[s][tau] = (f32x4){0.f, 0.f, 0.f, 0.f}; st[s][tau] = mfma16(k0, qf[s][0], st[s][tau]); st[s][tau] = mfma16(k1, qf[s][1], st[s][tau]); } } }
#pragma unroll
    for (int s = 0; s < 2; ++s) nsa_soft<MODE>(st[s], Bl, cl[s], fast, keybase, t[s], sel[s], m2[s], l[s], o[s], lfin[s], imp + s * 1024, lane);
    if (MODE != 0) {
        bf16x8 pb[2][2];
#pragma unroll
        for (int s = 0; s < 2; ++s) { pb[s][0] = pack_p(st[s][0], st[s][1]); pb[s][1] = pack_p(st[s][2], st[s][3]); }
#pragma unroll
        for (int dt = 0; dt < 4; ++dt) { const LAS bf16* vp = vt + (dt * 16 + (lane & 15)) * KT_LD + 8 * kg;
            const bf16x8 v0 = *(const LAS bf16x8*)(vp), v1 = *(const LAS bf16x8*)(vp + 32);
#pragma unroll
            for (int s = 0; s < 2; ++s) { o[s][dt] = mfma16(v0, pb[s][0], o[s][dt]); o[s][dt] = mfma16(v1, pb[s][1], o[s][dt]); } }
    }
}
template <int MODE>
__device__ __forceinline__ void dense_branch(LAS unsigned char* lds, const bf16* kbase, int ldk, const bf16* vbase, int ldv, int kb0, int nst, int tid, int lane,
                                             const bf16x8 (&qf)[2][2], const int (&t)[2], int tmin, float sl2, float (&m)[2], float (&l)[2], f32x4 (&o)[2][4], const float (&lfin)[2], LAS float* imp) {
    float Bl[16];
#pragma unroll
    for (int tau = 0; tau < 4; ++tau)
#pragma unroll
        for (int r = 0; r < 4; ++r) Bl[tau * 4 + r] = sl2 * (float)((MODE <= 1 ? 16 : 1) * (32 * (tau >> 1) + 8 * (lane >> 4) + 4 * (tau & 1) + r));
    const int srow = tid >> 3, sch = (tid & 7) * 8;
    const int krow = 16 * (2 * (srow >> 5) + ((srow >> 2) & 1)) + 4 * ((srow >> 3) & 3) + (srow & 3);
    const bool selt[2] = {true, true};
    v4u skA, svA;
#define DB_GLOAD(SK, SV, kb_) do { SK = *(const v4u*)(kbase + (size_t)((kb_) + srow) * ldk + sch); if (MODE != 0) SV = *(const v4u*)(vbase + (size_t)srow * ldv + (kb_) + sch); } while (0)
#define DB_LWRITE(SK, SV, buf_) do { LAS unsigned char* nb_ = lds + NSA_TILE0 + (buf_) * NSA_TILE_STRIDE; *(LAS v4u*)((LAS bf16*)nb_ + krow * KT_LD + sch) = SK; if (MODE != 0) *(LAS v4u*)((LAS bf16*)(nb_ + NSA_V_OFF) + srow * KT_LD + sch) = SV; } while (0)
#define DB_COMPUTE(kb_, buf_) do { const int kbb = (kb_); LAS unsigned char* cb_ = lds + NSA_TILE0 + (buf_) * NSA_TILE_STRIDE; \
        float cl[2]; cl[0] = (MODE <= 1) ? sl2 * (float)(16 * kbb + 31 - t[0]) : sl2 * (float)(kbb - t[0]); cl[1] = (MODE <= 1) ? sl2 * (float)(16 * kbb + 31 - t[1]) : sl2 * (float)(kbb - t[1]); \
        const bool fast = (MODE <= 1) ? (16 * (kbb + 63) + 31 <= tmin) : (kbb + 63 <= tmin && tmin + 7 - kbb < 512); \
        attn_step2<MODE>((const LAS bf16*)cb_, (const LAS bf16*)(cb_ + NSA_V_OFF), qf, Bl, cl, fast, kbb, t, selt, m, l, o, lfin, imp, lane); } while (0)
    if (nst > 0) { DB_GLOAD(skA, svA, kb0); DB_LWRITE(skA, svA, 0); }
    BAR_LDS();
#pragma unroll 1
    for (int s = 0; s < nst; ++s) {
        const int kb = kb0 + s * 64;
        if (s + 1 < nst) DB_GLOAD(skA, svA, kb + 64);
        DB_COMPUTE(kb, s & 1);
        if (s + 1 < nst) DB_LWRITE(skA, svA, (s + 1) & 1);
        BAR_LDS();
    }
#undef DB_GLOAD
#undef DB_LWRITE
#undef DB_COMPUTE
}
__device__ __forceinline__ void nsa_block(LAS unsigned char* lds, int b, int g, int t0b, int tid) {
    const int lane = tid & 63, wave = __builtin_amdgcn_readfirstlane(tid >> 6);
    LAS float* wl = (LAS float*)(lds + wave * NSA_WSTRIDE);
    const int t0 = t0b + 8 * wave;
    const int qi = lane & 15, kg = lane >> 4, tok = qi >> 2, hd = qi & 3;
    const int head = g * 4 + hd;
    const int t[2] = {t0 + tok, t0 + 4 + tok};
    const float sl2 = exp2f(-0.5f * (float)(head + 1)) * LOG2E;
    const size_t rowb = (size_t)b * SEQ;
    const int bg = b * 4 + g;
    bf16x8 qf[2][2];
    { const bf16* U2 = (const bf16*)(fresh_args()->ws + WS_R + R_U2);
#pragma unroll
      for (int s = 0; s < 2; ++s) { const bf16* qrow = U2 + (rowb + t[s]) * U2_LD + U2_Q + head * 64 + kg * 8; qf[s][0] = *(const bf16x8*)qrow; qf[s][1] = *(const bf16x8*)(qrow + 32); } }
#define NSA_GATE(s_, br_) sigm(bf2f(((const bf16*)(fresh_args()->ws + WS_R + R_U2))[(rowb + t[s_]) * U2_LD + U2_G + (br_) * 16 + head]))
    f32x4 o[2][4];
    LAS float* imp = wl;
    LAS f32x4* RES = (LAS f32x4*)wl;
    LAS u64* SELM = (LAS u64*)(wl + 2048);
#pragma unroll
    for (int i = 0; i < 8; ++i) *(LAS f32x4*)(imp + (i * 64 + lane) * 4) = (f32x4){0.f, 0.f, 0.f, 0.f};
    const int cur = t0b >> 6;
    const float zero2[2] = {0.f, 0.f};
    {
        unsigned char* wsr = fresh_args()->ws + WS_R;
        const bf16* kc = (const bf16*)(wsr + R_KCMP) + (size_t)bg * 1024 * 64; const bf16* vct = (const bf16*)(wsr + R_VCMPT) + (size_t)bg * 64 * 1024;
        const int nsteps = (((t0b + 32) >> 4) >> 6) + 1;
        float m[2] = {-1e30f, -1e30f}, l[2] = {0.f, 0.f};
        dense_branch<0>(lds, kc, 64, vct, 1024, 0, nsteps, tid, lane, qf, t, t0, sl2, m, l, o, zero2, imp);
        float lfin[2];
#pragma unroll
        for (int s = 0; s < 2; ++s) { l[s] = xrow16_sum(l[s]); lfin[s] = m[s] + __builtin_amdgcn_logf(fmaxf(l[s], TINYF));
#pragma unroll
            for (int dt = 0; dt < 4; ++dt) o[s][dt] = (f32x4){0.f, 0.f, 0.f, 0.f}; }
        dense_branch<1>(lds, kc, 64, vct, 1024, 0, nsteps, tid, lane, qf, t, t0, sl2, m, l, o, lfin, imp);
#pragma unroll
        for (int s = 0; s < 2; ++s)
#pragma unroll
            for (int dt = 0; dt < 4; ++dt) o[s][dt] = o[s][dt] * NSA_GATE(s, 0);
    }
    LDS_WAIT();
    u64 w0 = 0ull, w1 = 0ull, w2 = 0ull, w3 = 0ull;
    {
        const int ncand = cur - 2 > 0 ? cur - 2 : 0; const int nsel = ncand < 13 ? ncand : 13;
#pragma unroll 1
        for (int tk = 0; tk < 8; ++tk) {
            unsigned k0 = 0u, k1 = 0u, k2 = 0u, k3 = 0u;
            { const int j0 = lane, j1 = lane + 64, j2 = lane + 128, j3 = lane + 192;
              if (j0 >= 1 && j0 <= cur - 2) k0 = (__float_as_uint(imp[tk * 256 + j0]) & 0xffffff00u) | (unsigned)(255 - j0);
              if (j1 <= cur - 2) k1 = (__float_as_uint(imp[tk * 256 + j1]) & 0xffffff00u) | (unsigned)(255 - j1);
              if (j2 <= cur - 2) k2 = (__float_as_uint(imp[tk * 256 + j2]) & 0xffffff00u) | (unsigned)(255 - j2);
              if (j3 <= cur - 2) k3 = (__float_as_uint(imp[tk * 256 + j3]) & 0xffffff00u) | (unsigned)(255 - j3); }
            unsigned sb = 0u;
            for (int it = 0; it < nsel; ++it) {
                const unsigned best = wave_max_u32(max(max(k0, k1), max(k2, k3)));
                const int bi = 255 - (int)(best & 0xffu);
                if ((bi & 63) == lane) { const int ii = bi >> 6; sb |= 1u << ii; if (ii == 0) k0 = 0u; else if (ii == 1) k1 = 0u; else if (ii == 2) k2 = 0u; else k3 = 0u; }
            }
            u64 m0 = __ballot((sb & 1u) != 0u), m1 = __ballot((sb & 2u) != 0u), m2 = __ballot((sb & 4u) != 0u), m3 = __ballot((sb & 8u) != 0u);
            m0 |= 1ull;
            { const int w = cur >> 6; const u64 bit = 1ull << (cur & 63); if (w == 0) m0 |= bit; else if (w == 1) m1 |= bit; else if (w == 2) m2 |= bit; else m3 |= bit; }
            if (cur >= 1) { const int c1 = cur - 1; const int w = c1 >> 6; const u64 bit = 1ull << (c1 & 63); if (w == 0) m0 |= bit; else if (w == 1) m1 |= bit; else if (w == 2) m2 |= bit; else m3 |= bit; }
            if (lane == 0) { SELM[tk * 4 + 0] = m0; SELM[tk * 4 + 1] = m1; SELM[tk * 4 + 2] = m2; SELM[tk * 4 + 3] = m3; }
            w0 |= m0; w1 |= m1; w2 |= m2; w3 |= m3;
        }
    }
#pragma unroll
    for (int s = 0; s < 2; ++s)
#pragma unroll
        for (int dt = 0; dt < 4; ++dt) RES[(s * 4 + dt) * 64 + lane] = o[s][dt];
    LAS u64* XCH = (LAS u64*)(lds + NSA_XCH);
    if (lane == 0) { XCH[wave * 4 + 0] = w0; XCH[wave * 4 + 1] = w1; XCH[wave * 4 + 2] = w2; XCH[wave * 4 + 3] = w3; }
    BAR_LDS();
    u64 u0 = 0ull, u1 = 0ull, u2 = 0ull, u3 = 0ull;
#pragma unroll
    for (int w = 0; w < 8; ++w) { u0 |= XCH[w * 4 + 0]; u1 |= XCH[w * 4 + 1]; u2 |= XCH[w * 4 + 2]; u3 |= XCH[w * 4 + 3]; }
    u0 = ((u64)__builtin_amdgcn_readfirstlane((unsigned)(u0 >> 32)) << 32) | (u64)__builtin_amdgcn_readfirstlane((unsigned)u0);
    u1 = ((u64)__builtin_amdgcn_readfirstlane((unsigned)(u1 >> 32)) << 32) | (u64)__builtin_amdgcn_readfirstlane((unsigned)u1);
    u2 = ((u64)__builtin_amdgcn_readfirstlane((unsigned)(u2 >> 32)) << 32) | (u64)__builtin_amdgcn_readfirstlane((unsigned)u2);
    u3 = ((u64)__builtin_amdgcn_readfirstlane((unsigned)(u3 >> 32)) << 32) | (u64)__builtin_amdgcn_readfirstlane((unsigned)u3);
    {
        unsigned char* wsr = fresh_args()->ws + WS_R;
        const bf16* ksb = (const bf16*)(wsr + R_U2) + rowb * U2_LD + U2_KS + g * 64; const bf16* vsb = (const bf16*)(wsr + R_VST) + (size_t)bg * 64 * SEQ;
        float m[2] = {-1e30f, -1e30f}, l[2] = {0.f, 0.f};
#pragma unroll
        for (int s = 0; s < 2; ++s)
#pragma unroll
            for (int dt = 0; dt < 4; ++dt) o[s][dt] = (f32x4){0.f, 0.f, 0.f, 0.f};
        const int srow = tid >> 3, sch = (tid & 7) * 8;
        const int krow = 16 * (2 * (srow >> 5) + ((srow >> 2) & 1)) + 4 * ((srow >> 3) & 3) + (srow & 3);
        v4u skA, svA;
        float Bl[16];
#pragma unroll
        for (int tau = 0; tau < 4; ++tau)
#pragma unroll
            for (int r = 0; r < 4; ++r) Bl[tau * 4 + r] = sl2 * (float)(32 * (tau >> 1) + 8 * kg + 4 * (tau & 1) + r);
#define SL_GLOAD(SK, SV, j_) do { SK = *(const v4u*)(ksb + (size_t)((j_) * 64 + srow) * U2_LD + sch); SV = *(const v4u*)(vsb + (size_t)srow * SEQ + (j_) * 64 + sch); } while (0)
#define SL_LWRITE(SK, SV, buf_) do { LAS unsigned char* nb_ = lds + NSA_TILE0 + (buf_) * NSA_TILE_STRIDE; *(LAS v4u*)((LAS bf16*)nb_ + krow * KT_LD + sch) = SK; *(LAS v4u*)((LAS bf16*)(nb_ + NSA_V_OFF) + srow * KT_LD + sch) = SV; } while (0)
#define SL_COMPUTE(j_, buf_) do { const int jj = (j_); const int wd = jj >> 6; const u64 wword = wd == 0 ? w0 : wd == 1 ? w1 : wd == 2 ? w2 : w3; \
            if ((wword >> (jj & 63)) & 1ull) { LAS unsigned char* cb_ = lds + NSA_TILE0 + (buf_) * NSA_TILE_STRIDE; \
                bool sel[2]; sel[0] = ((SELM[tok * 4 + wd] >> (jj & 63)) & 1ull) != 0ull; sel[1] = ((SELM[(tok + 4) * 4 + wd] >> (jj & 63)) & 1ull) != 0ull; \
                const bool fast = (jj < cur);     \
                float cl[2]; cl[0] = (sel[0] || !fast) ? sl2 * (float)(jj * 64 - t[0]) : -INFINITY; cl[1] = (sel[1] || !fast) ? sl2 * (float)(jj * 64 - t[1]) : -INFINITY; \
                attn_step2<2>((const LAS bf16*)cb_, (const LAS bf16*)(cb_ + NSA_V_OFF), qf, Bl, cl, fast, jj * 64, t, sel, m, l, o, zero2, imp, lane); } } while (0)
        int jc = pop_bit(u0, u1, u2, u3);
        SL_GLOAD(skA, svA, jc); SL_LWRITE(skA, svA, 0);
        BAR_LDS();
        int sidx = 0;
#pragma unroll 1
        while (jc >= 0) {
            const int jn = pop_bit(u0, u1, u2, u3);
            if (jn >= 0) SL_GLOAD(skA, svA, jn);
            SL_COMPUTE(jc, sidx & 1);
            if (jn >= 0) SL_LWRITE(skA, svA, (sidx + 1) & 1);
            BAR_LDS();
            jc = jn; ++sidx;
        }
#undef SL_GLOAD
#undef SL_LWRITE
#undef SL_COMPUTE
#pragma unroll
        for (int s = 0; s < 2; ++s) { l[s] = xrow16_sum(l[s]); const float sc = NSA_GATE(s, 1) * __builtin_amdgcn_rcpf(fmaxf(l[s], TINYF));
#pragma unroll
            for (int dt = 0; dt < 4; ++dt) RES[(s * 4 + dt) * 64 + lane] = RES[(s * 4 + dt) * 64 + lane] + o[s][dt] * sc; }
    }
    {
        unsigned char* wsr = fresh_args()->ws + WS_R;
        const bf16* kwb = (const bf16*)(wsr + R_U2) + rowb * U2_LD + U2_KW + g * 64; const bf16* vwb = (const bf16*)(wsr + R_VWT) + (size_t)bg * 64 * SEQ;
        const int lo = t0b - 511 > 0 ? t0b - 511 : 0; const int base0 = lo & ~63; const int nsteps = ((t0b + 63) >> 6) - (base0 >> 6) + 1;
        float m[2] = {-1e30f, -1e30f}, l[2] = {0.f, 0.f};
#pragma unroll
        for (int s = 0; s < 2; ++s)
#pragma unroll
            for (int dt = 0; dt < 4; ++dt) o[s][dt] = (f32x4){0.f, 0.f, 0.f, 0.f};
        dense_branch<3>(lds, kwb, U2_LD, vwb, SEQ, base0, nsteps, tid, lane, qf, t, t0, sl2, m, l, o, zero2, imp);
#pragma unroll
        for (int s = 0; s < 2; ++s) { l[s] = xrow16_sum(l[s]); const float sc = NSA_GATE(s, 2) * __builtin_amdgcn_rcpf(fmaxf(l[s], TINYF));
#pragma unroll
            for (int dt = 0; dt < 4; ++dt) o[s][dt] = RES[(s * 4 + dt) * 64 + lane] + o[s][dt] * sc; }
    }
#pragma unroll
    for (int s = 0; s < 2; ++s) { bf16* orow = (bf16*)(fresh_args()->ws + WS_HB) + (rowb + t[s]) * DM + 1024 + head * 64 + kg * 4;
#pragma unroll
        for (int dt = 0; dt < 4; ++dt) { v2u w; w.x = pk2(o[s][dt][0], o[s][dt][1]); w.y = pk2(o[s][dt][2], o[s][dt][3]); *(v2u*)(orow + dt * 16) = w; } }
}
constexpr int QLD = 136, TLD = 72;
constexpr int H_QT = 0, H_KT = 17408, H_KTT = 34816, H_IT = 53248, H_SEG = 71680, H_DB = 73728, H_GN = 74240, H_RAWQ = 76800, H_RAWF = 93184, H_RAWI = 109568;
struct HTiles { v4u a[2], b[2], c[2]; };
__device__ __forceinline__ void hgrn_load_raw(HTiles& R, const bf16* UB, int unit, int tid) {
    const int h = unit >> 8, s0 = (unit & 255) * 64;
#pragma unroll
    for (int i = 0; i < 2; ++i) { const int cix = tid + 512 * i, row = cix >> 4, ch = (cix & 15) * 8; const bf16* gp = UB + (size_t)(s0 + row) * OD_N + h * 128 + ch;
        R.a[i] = *(const v4u*)gp; R.b[i] = *(const v4u*)(gp + 2048); R.c[i] = *(const v4u*)(gp + 4096); }
}
__device__ __forceinline__ void hgrn_prep(const HTiles& R, const float* gamma, int h, LAS unsigned char* lds, int tid, float* vec) {
    const int k = tid & 127, seg = tid >> 7, col = h * 128 + k;
    const float lb = 1.0f / (1.0f + __expf(gamma[col] - gamma[2048 + col]));
    LAS float* SEG = (LAS float*)(lds + H_SEG);
    LAS bf16* QT = (LAS bf16*)(lds + H_QT); LAS bf16* KT = (LAS bf16*)(lds + H_KT); LAS bf16* KTT = (LAS bf16*)(lds + H_KTT); LAS bf16* IT = (LAS bf16*)(lds + H_IT);
    float lf[16], kk[16], qv[16]; unsigned iv[16];
    { LAS bf16* RQ = (LAS bf16*)(lds + H_RAWQ); LAS bf16* RF = (LAS bf16*)(lds + H_RAWF); LAS bf16* RI = (LAS bf16*)(lds + H_RAWI);
#pragma unroll
      for (int i = 0; i < 2; ++i) { const int cix = tid + 512 * i, row = cix >> 4, ch = (cix & 15) * 8;
          *(LAS v4u*)(RQ + row * 128 + ch) = R.a[i]; *(LAS v4u*)(RF + row * 128 + ch) = R.b[i]; *(LAS v4u*)(RI + row * 128 + ch) = R.c[i]; }
      BAR_LDS();
#pragma unroll
      for (int j = 0; j < 16; ++j) { const int ro = (seg * 16 + j) * 128 + k; qv[j] = bf2f(RQ[ro]); const float x = bf2f(RF[ro]); iv[j] = RI[ro];
          const float f = lb + (1.0f - lb) * sigm(x); lf[j] = __builtin_amdgcn_logf(fmaxf(f, TINYF)) * 0.6931471805599453f; kk[j] = 1.0f - f; } }
    float c = 0.f;
#pragma unroll
    for (int j = 0; j < 16; ++j) { c += lf[j]; lf[j] = c; }
    SEG[seg * 128 + k] = c;
    BAR_LDS();
    const float s0v = SEG[k], s1v = SEG[128 + k], s2v = SEG[256 + k], s3v = SEG[384 + k];
    const float pre = seg == 0 ? 0.f : seg == 1 ? s0v : seg == 2 ? s0v + s1v : s0v + s1v + s2v;
    const float gref = s0v + s1v, glast = (s0v + s1v) + (s2v + s3v);
    unsigned kt16[16];
#pragma unroll
    for (int j = 0; j < 16; ++j) { const float G = pre + lf[j]; const unsigned qb = f2bf(qv[j] * __expf(G - gref)), kb = f2bf(kk[j] * __expf(gref - G));
        QT[(seg * 16 + j) * QLD + k] = (bf16)qb; KT[(seg * 16 + j) * QLD + k] = (bf16)kb; kt16[j] = kb; }
    { v4u a, b2; a.x = kt16[0] | (kt16[1] << 16); a.y = kt16[2] | (kt16[3] << 16); a.z = kt16[4] | (kt16[5] << 16); a.w = kt16[6] | (kt16[7] << 16);
      b2.x = kt16[8] | (kt16[9] << 16); b2.y = kt16[10] | (kt16[11] << 16); b2.z = kt16[12] | (kt16[13] << 16); b2.w = kt16[14] | (kt16[15] << 16);
      *(LAS v4u*)(KTT + k * TLD + seg * 16) = a; *(LAS v4u*)(KTT + k * TLD + seg * 16 + 8) = b2; }
    { v4u a, b2; a.x = iv[0] | (iv[1] << 16); a.y = iv[2] | (iv[3] << 16); a.z = iv[4] | (iv[5] << 16); a.w = iv[6] | (iv[7] << 16);
      b2.x = iv[8] | (iv[9] << 16); b2.y = iv[10] | (iv[11] << 16); b2.z = iv[12] | (iv[13] << 16); b2.w = iv[14] | (iv[15] << 16);
      *(LAS v4u*)(IT + k * TLD + seg * 16) = a; *(LAS v4u*)(IT + k * TLD + seg * 16 + 8) = b2; }
    if (seg == 0) { ((LAS float*)(lds + H_DB))[k] = __expf(glast - gref); if (vec) { vec[k] = __expf(glast); vec[128 + k] = __expf(gref); } }
    BAR_LDS();
}
__device__ __forceinline__ void hgrn_passA(bf16* UB, const float* gamma, bf16* ZS, float* VEC, bf16* ITG, int unit, const HTiles& R, LAS unsigned char* lds, int tid) {
    const int h = unit >> 8, c = unit & 255, lane = tid & 63, w = tid >> 6;
    hgrn_prep(R, gamma, h, lds, tid, VEC + (size_t)unit * 256);
    const LAS bf16* KTT = (const LAS bf16*)(lds + H_KTT); const LAS bf16* IT = (const LAS bf16*)(lds + H_IT); const LAS float* DB = (const LAS float*)(lds + H_DB);
    f32x4 acc[8];
#pragma unroll
    for (int vt = 0; vt < 8; ++vt) acc[vt] = (f32x4){0.f, 0.f, 0.f, 0.f};
#pragma unroll
    for (int ks = 0; ks < 2; ++ks) { const bf16x8 a = *(const LAS bf16x8*)(KTT + (16 * w + (lane & 15)) * TLD + 32 * ks + 8 * (lane >> 4));
#pragma unroll
        for (int vt = 0; vt < 8; ++vt) { const bf16x8 bb = *(const LAS bf16x8*)(IT + (16 * vt + (lane & 15)) * TLD + 32 * ks + 8 * (lane >> 4)); acc[vt] = mfma16(a, bb, acc[vt]); } }
    const int k0 = 16 * w + 4 * (lane >> 4);
    const float d0 = DB[k0], d1 = DB[k0 + 1], d2 = DB[k0 + 2], d3 = DB[k0 + 3];
#pragma unroll
    for (int vt = 0; vt < 8; ++vt) { const int v = 16 * vt + (lane & 15); v2u o; o.x = pk2(acc[vt][0] * d0, acc[vt][1] * d1); o.y = pk2(acc[vt][2] * d2, acc[vt][3] * d3);
        *(v2u*)(ZS + ((size_t)unit * 128 + v) * 128 + k0) = o; }
    { const LAS bf16* QT = (const LAS bf16*)(lds + H_QT); const LAS bf16* KT = (const LAS bf16*)(lds + H_KT);
#pragma unroll
      for (int i = 0; i < 2; ++i) { const int cix = tid + 512 * i, row = cix >> 4, ch = (cix & 15) * 8; bf16* gp = UB + (size_t)(c * 64 + row) * OD_N + h * 128 + ch;
          *(v4u*)gp = *(const LAS v4u*)(QT + row * QLD + ch); *(v4u*)(gp + 2048) = *(const LAS v4u*)(KT + row * QLD + ch); }
#pragma unroll
      for (int i = 0; i < 2; ++i) { const int cix = tid + 512 * i, v = cix >> 3, ch = (cix & 7) * 8; *(v4u*)(ITG + (size_t)unit * 8192 + v * 64 + ch) = *(const LAS v4u*)(IT + v * TLD + ch); } }
    BAR_LDS();
}
__device__ __forceinline__ void hgrn_scan(bf16* ZS, const float* VEC, int gthread, int nthreads) {
    for (int e2 = gthread; e2 < 16 * 8192; e2 += nthreads) {
        const int h = e2 >> 13, rem = (e2 & 8191) * 2, k = rem & 127;
        float st0 = 0.f, st1 = 0.f;
        for (int c0 = 0; c0 < 256; c0 += 32) {
            unsigned z[32]; f32x2 da[32], dc[32];
#pragma unroll
            for (int i = 0; i < 32; ++i) { const size_t unit = (size_t)h * 256 + c0 + i; z[i] = *(const unsigned*)(ZS + unit * 16384 + rem); da[i] = *(const f32x2*)(VEC + unit * 256 + k); dc[i] = *(const f32x2*)(VEC + unit * 256 + 128 + k); }
#pragma unroll
            for (int i = 0; i < 32; ++i) { const size_t unit = (size_t)h * 256 + c0 + i; *(unsigned*)(ZS + unit * 16384 + rem) = pk2(dc[i].x * st0, dc[i].y * st1);
                st0 = da[i].x * st0 + bflo(z[i]); st1 = da[i].y * st1 + bfhi(z[i]); }
        }
    }
}
__device__ __forceinline__ void hgrn_load_c(HTiles& R, const bf16* UB, const bf16* ITG, int unit, int tid) {
    const int h = unit >> 8, c = unit & 255;
#pragma unroll
    for (int i = 0; i < 2; ++i) { const int cix = tid + 512 * i, row = cix >> 4, ch = (cix & 15) * 8; const bf16* gp = UB + (size_t)(c * 64 + row) * OD_N + h * 128 + ch;
        R.a[i] = *(const v4u*)gp; R.b[i] = *(const v4u*)(gp + 2048); R.c[i] = *(const v4u*)(ITG + (size_t)unit * 8192 + (size_t)cix * 8); }
}
__device__ __forceinline__ void hgrn_passC(const bf16* UB, const bf16* ITG, const bf16* ZS, const float* gw, bf16* MIXB, int unit, int next_unit, HTiles& R, LAS unsigned char* lds, int tid) {
    const int h = unit >> 8, c = unit & 255, lane = tid & 63, w = tid >> 6, tt = w & 3, vh = w >> 2, kg = lane >> 4, tq = lane & 15;
    const int tl = 16 * tt + tq; const size_t row = (size_t)c * 64 + tl;
    { LAS bf16* QTw = (LAS bf16*)(lds + H_QT); LAS bf16* KTw = (LAS bf16*)(lds + H_KT); LAS bf16* ITw = (LAS bf16*)(lds + H_IT);
#pragma unroll
      for (int i = 0; i < 2; ++i) { const int cix = tid + 512 * i, rw = cix >> 4, ch = (cix & 15) * 8;
          *(LAS v4u*)(QTw + rw * QLD + ch) = R.a[i]; *(LAS v4u*)(KTw + rw * QLD + ch) = R.b[i]; *(LAS v4u*)(ITw + (cix >> 3) * TLD + (cix & 7) * 8) = R.c[i]; } }
    bf16x8 sf[4][4]; v2u gg[4];
#pragma unroll
    for (int vt = 0; vt < 4; ++vt) { const int vrow = 64 * vh + 16 * vt + tq; const bf16* sp = ZS + ((size_t)unit * 128 + vrow) * 128 + 8 * kg;
#pragma unroll
        for (int ks = 0; ks < 4; ++ks) sf[vt][ks] = *(const bf16x8*)(sp + 32 * ks);
        gg[vt] = *(const v2u*)(UB + row * OD_N + 6144 + h * 128 + 64 * vh + 16 * vt + 4 * kg); }
    BAR_LDS();
    if (next_unit >= 0) hgrn_load_c(R, UB, ITG, next_unit, tid);
    const LAS bf16* QT = (const LAS bf16*)(lds + H_QT); const LAS bf16* KT = (const LAS bf16*)(lds + H_KT); const LAS bf16* IT = (const LAS bf16*)(lds + H_IT); LAS float* GN = (LAS float*)(lds + H_GN);
    bf16x8 qf[4];
#pragma unroll
    for (int ks = 0; ks < 4; ++ks) qf[ks] = *(const LAS bf16x8*)(QT + (16 * tt + tq) * QLD + 32 * ks + 8 * kg);
    f32x4 st[4];
    const int ro = 8 * (tq >> 2) + (tq & 3);
#pragma unroll
    for (int tau = 0; tau < 4; ++tau) { st[tau] = (f32x4){0.f, 0.f, 0.f, 0.f}; const int srow = 32 * (tau >> 1) + 4 * (tau & 1) + ro;
#pragma unroll
        for (int ks = 0; ks < 4; ++ks) { const bf16x8 a = *(const LAS bf16x8*)(KT + srow * QLD + 32 * ks + 8 * kg); st[tau] = mfma16(a, qf[ks], st[tau]); } }
#pragma unroll
    for (int tau = 0; tau < 4; ++tau)
#pragma unroll
        for (int r = 0; r < 4; ++r) { const int s = 32 * (tau >> 1) + 8 * kg + 4 * (tau & 1) + r; if (s > tl) st[tau][r] = 0.f; }
    const bf16x8 pb0 = pack_p(st[0], st[1]), pb1 = pack_p(st[2], st[3]);
    f32x4 o[4];
#pragma unroll
    for (int vt = 0; vt < 4; ++vt) { o[vt] = (f32x4){0.f, 0.f, 0.f, 0.f}; const int vrow = 64 * vh + 16 * vt + tq;
        const bf16x8 i0 = *(const LAS bf16x8*)(IT + vrow * TLD + 8 * kg), i1 = *(const LAS bf16x8*)(IT + vrow * TLD + 32 + 8 * kg);
        o[vt] = mfma16(i0, pb0, o[vt]); o[vt] = mfma16(i1, pb1, o[vt]);
#pragma unroll
        for (int ks = 0; ks < 4; ++ks) o[vt] = mfma16(sf[vt][ks], qf[ks], o[vt]); }
    float ss = 0.f;
#pragma unroll
    for (int vt = 0; vt < 4; ++vt) ss += (o[vt][0] * o[vt][0] + o[vt][1] * o[vt][1]) + (o[vt][2] * o[vt][2] + o[vt][3] * o[vt][3]);
    ss = xrow16_sum(ss);
    if (kg == 0) GN[vh * 64 + tl] = ss;
    BAR_LDS();
    const float rn = rsqrtf((GN[tl] + GN[64 + tl]) * (1.f / 128.f) + EPS);
#pragma unroll
    for (int vt = 0; vt < 4; ++vt) { const int colv = h * 128 + 64 * vh + 16 * vt + 4 * kg;
        const f32x4 gwv = *(const f32x4*)(gw + colv);
        const float g0 = bflo(gg[vt].x), g1 = bfhi(gg[vt].x), g2 = bflo(gg[vt].y), g3 = bfhi(gg[vt].y);
        v2u ov; ov.x = pk2(o[vt][0] * rn * gwv.x * g0 * sigm(g0), o[vt][1] * rn * gwv.y * g1 * sigm(g1)); ov.y = pk2(o[vt][2] * rn * gwv.z * g2 * sigm(g2), o[vt][3] * rn * gwv.w * g3 * sigm(g3));
        *(v2u*)(MIXB + row * DM + colv) = ov; }
    BAR_LDS();
}
__device__ __forceinline__ void ph_prologue(LAS unsigned char* lds) {
    KA ka = fresh_args(); const int tid = fresh_tid(), lane = tid & 63, wave = tid >> 6;
    const int G = gridDim.x, bx = blockIdx.x, gw = bx * NWAVES + wave, NGW = G * NWAVES, gthread = bx * NTHREADS + tid, NTH = G * NTHREADS;
    bf16* W_EVIN = (bf16*)WSP(ka, WS_W_EVIN);
    LAS float* scr = (LAS float*)(lds + wave * 16640);
    const int n_evin = 32 * 73, n_sq = 32 * 32, n_odin = 32 * 128, n_gu = 32 * 176, n_dn = 88 * 32, n_c1 = 32 * 4;
    const int total = n_evin + n_sq + n_odin + n_sq + 2 * n_gu + 2 * n_dn + 2 * n_c1;
    for (int it = gw; it < total; it += NGW) {
        int r = it;
        if (r < n_evin) { tr_item(ka->in[I_EVWIN], DM, EV_REAL, W_EVIN, scr, r, lane, 1024, 2048, 2048, 3072, 0.125f); continue; } r -= n_evin;
        if (r < n_sq) { tr_item(ka->in[I_EVWOUT], DM, DM, (bf16*)WSP(ka, WS_W_EVOUT), scr, r, lane, 0, 0, 0, 0, 1.f); continue; } r -= n_sq;
        if (r < n_odin) { tr_item(ka->in[I_ODWIN], DM, OD_N, (bf16*)WSP(ka, WS_W_ODIN), scr, r, lane, 0, 0, 0, 0, 1.f); continue; } r -= n_odin;
        if (r < n_sq) { tr_item(ka->in[I_ODWOUT], DM, DM, (bf16*)WSP(ka, WS_W_ODOUT), scr, r, lane, 0, 0, 0, 0, 1.f); continue; } r -= n_sq;
        if (r < 2 * n_gu) { const int l = r / n_gu; tr_item(ka->in[I_WGU] + (size_t)l * DM * 2 * FF, DM, 2 * FF, (bf16*)WSP(ka, WS_W_GU) + (size_t)l * 2 * FF * DM, scr, r - l * n_gu, lane, FF, 2 * FF, 0, 0, 1.f); continue; } r -= 2 * n_gu;
        if (r < 2 * n_dn) { const int l = r / n_dn; tr_item(ka->in[I_WDN] + (size_t)l * FF * DM, FF, DM, (bf16*)WSP(ka, WS_W_DN) + (size_t)l * DM * FF, scr, r - l * n_dn, lane, 0, 0, 0, 0, 1.f); continue; } r -= 2 * n_dn;
        { const int l = r / n_c1; tr_item(ka->in[I_CW1] + (size_t)l * 2048 * 256, 2048, 256, (bf16*)WSP(ka, WS_W_C1) + (size_t)l * 256 * 2048, scr, r - l * n_c1, lane, 0, 0, 0, 0, 1.f); }
    }
    for (int i = gthread; i < (EV_N - EV_REAL) * DM / 8; i += NTH) *(v4u*)(W_EVIN + (size_t)EV_REAL * DM + (size_t)i * 8) = (v4u){0u, 0u, 0u, 0u};
    if (gw < 512) { const int wv = gw >> 8, cc = gw & 255; const float* pos = ka->in[I_CPOS] + wv * 2048; const float* w1 = ka->in[I_CW1] + (size_t)wv * 2048 * 256 + cc;
        float s = 0.f; for (int kx = lane; kx < 2048; kx += 64) s += pos[kx] * w1[(size_t)kx * 256];
        s = wave_sum(s); if (lane == 0) ((float*)WSP(ka, WS_SMALL))[gw] = s + ka->in[I_CB1][wv * 256 + cc]; }
    norm_rows(ka->in[I_X], ka->in[I_NORMW], (bf16*)WSP(ka, WS_HB), nullptr, gw, NGW, lane);
}
__device__ __forceinline__ void ph_norm(int which) {
    KA ka = fresh_args(); const int tid = fresh_tid(), lane = tid & 63, wave = tid >> 6;
    const int gw = blockIdx.x * NWAVES + wave, NGW = gridDim.x * NWAVES;
    const float* w = which == 0 ? ka->in[I_NORMW] + DM : which == 1 ? ka->in[I_NORMW] + 2 * DM : which == 2 ? ka->in[I_NORMW] + 3 * DM : ka->in[I_FNW];
    if (which == 3) norm_rows(ka->out, w, nullptr, ka->out, gw, NGW, lane);
    else norm_rows(ka->out, w, (bf16*)WSP(ka, WS_HB), nullptr, gw, NGW, lane);
}
__device__ __forceinline__ void ph_conv(LAS unsigned char* lds) {
    KA ka = fresh_args(); const int tid = fresh_tid();
    const int G = gridDim.x, bx = blockIdx.x, gthread = bx * NTHREADS + tid, NTH = G * NTHREADS;
    bf16* U2 = (bf16*)RP(ka, R_U2);
#ifndef SKIP_CONV
    for (int tile = bx; tile < T / 16; tile += G) conv_tile((const bf16*)RP(ka, R_HGLU), ka->in[I_CONVW], ka->in[I_CONVB], ka->in[I_LNW], ka->in[I_LNB], (bf16*)WSP(ka, WS_HB), lds, tile, tid);
#endif
    bf16* ACMP = (bf16*)RP(ka, R_ACMP);
    for (int ch0 = gthread; ch0 < 2 * 8192 * 256; ch0 += 8 * NTH) {
        v4u v[8];
#pragma unroll
        for (int q = 0; q < 8; ++q) { const int ch = ch0 + q * NTH;
            const int c8 = ch & 7, j = (ch >> 3) & 31, row = (ch >> 8) & 8191, wv = ch >> 21; const int n = row & 1023, bgx = row >> 10, b = bgx >> 2, g = bgx & 3;
            v[q] = (v4u){0u, 0u, 0u, 0u};
            if (ch < 2 * 8192 * 256 && n < 1023) v[q] = *(const v4u*)(U2 + ((size_t)b * SEQ + 16 * n + j) * U2_LD + (wv ? U2_VC : U2_KC) + g * 64 + c8 * 8); }
#pragma unroll
        for (int q = 0; q < 8; ++q) { const int ch = ch0 + q * NTH; if (ch < 2 * 8192 * 256) *(v4u*)(ACMP + (size_t)ch * 8) = v[q]; }
    }
    bf16* VST = (bf16*)RP(ka, R_VST); bf16* VWT = (bf16*)RP(ka, R_VWT);
    for (int ch0 = gthread; ch0 < 2 * NB * 4 * 64 * (SEQ / 8); ch0 += 4 * NTH) {
        unsigned e[4][8];
#pragma unroll
        for (int q = 0; q < 4; ++q) { const int ch = ch0 + q * NTH; const int d = ch & 63, s8 = (ch >> 6) & 2047, bgx = (ch >> 17) & 7, wv = (ch >> 20) & 1; const int b = bgx >> 2, g = bgx & 3;
            const bf16* src = U2 + ((size_t)b * SEQ + s8 * 8) * U2_LD + (wv ? U2_VW : U2_VS) + g * 64 + d;
#pragma unroll
            for (int i = 0; i < 8; ++i) e[q][i] = (ch < 2 * NB * 4 * 64 * (SEQ / 8)) ? src[(size_t)i * U2_LD] : 0u; }
#pragma unroll
        for (int q = 0; q < 4; ++q) { const int ch = ch0 + q * NTH; const int d = ch & 63, s8 = (ch >> 6) & 2047, bgx = (ch >> 17) & 7, wv = (ch >> 20) & 1;
            v4u v; v.x = e[q][0] | (e[q][1] << 16); v.y = e[q][2] | (e[q][3] << 16); v.z = e[q][4] | (e[q][5] << 16); v.w = e[q][6] | (e[q][7] << 16);
            if (ch < 2 * NB * 4 * 64 * (SEQ / 8)) *(v4u*)((wv ? VWT : VST) + ((size_t)bgx * 64 + d) * SEQ + s8 * 8) = v; }
    }
}
__device__ __forceinline__ void ph_cmp2() {
    KA ka = fresh_args(); const int tid = fresh_tid();
    const int gthread = blockIdx.x * NTHREADS + tid, NTH = gridDim.x * NTHREADS;
    const bf16* HID = (const bf16*)RP(ka, R_HID); bf16* KCMP = (bf16*)RP(ka, R_KCMP); bf16* VCMPT = (bf16*)RP(ka, R_VCMPT);
    for (int o = gthread; o < 2 * 8192 * 64; o += NTH) {
        const int d = o & 63, row = (o >> 6) & 8191, wv = o >> 19; const int n = row & 1023, bgx = row >> 10;
        float s = 0.f;
        if (n < 1023) { const bf16* hp = HID + ((size_t)wv * 8192 + row) * 256; const float* w2 = ka->in[I_CW2] + (size_t)wv * 256 * 64 + d;
            s = ka->in[I_CB2][wv * 64 + d];
#pragma unroll 8
            for (int k8 = 0; k8 < 32; ++k8) { const v4u hv = *(const v4u*)(hp + k8 * 8); const float* wp = w2 + (size_t)k8 * 8 * 64;
                s += bflo(hv.x) * wp[0] + bfhi(hv.x) * wp[64] + bflo(hv.y) * wp[128] + bfhi(hv.y) * wp[192] + bflo(hv.z) * wp[256] + bfhi(hv.z) * wp[320] + bflo(hv.w) * wp[384] + bfhi(hv.w) * wp[448]; } }
        if (wv == 0) KCMP[((size_t)bgx * 1024 + n) * 64 + d] = (bf16)f2bf(s); else VCMPT[((size_t)bgx * 64 + d) * 1024 + n] = (bf16)f2bf(s);
    }
}
__device__ __forceinline__ void ph_nsa(LAS unsigned char* lds) {
#ifndef SKIP_NSA
    const int tid = fresh_tid();
    const int G = gridDim.x, bx = blockIdx.x;
    const bool xm = (G & 7) == 0;
    const int nW = xm ? (G >> 3) : G, w0 = xm ? (bx >> 3) : bx, total = xm ? SEQ / 64 : 8 * (SEQ / 64);
#pragma unroll 1
    for (int u = w0, it = 0; u < total; u += nW, ++it) { const int bgx = xm ? ((bx + it) & 7) : u / (SEQ / 64), t64 = xm ? u : u % (SEQ / 64); nsa_block(lds, bgx >> 2, bgx & 3, t64 * 64, tid); }
#endif
}
__device__ __forceinline__ void ph_hgrnA(LAS unsigned char* lds) {
#ifndef SKIP_HGRN
    KA ka = fresh_args(); const int tid = fresh_tid();
    bf16* UB = (bf16*)RP(ka, R_UB);
    HTiles R; if ((int)blockIdx.x < 4096) hgrn_load_raw(R, UB, blockIdx.x, tid);
#pragma unroll 1
    for (int unit = blockIdx.x; unit < 4096; unit += gridDim.x) {
        HTiles Rc = R; const int nu = unit + gridDim.x;
        if (nu < 4096) hgrn_load_raw(R, UB, nu, tid);
        hgrn_passA(UB, ka->in[I_GAMMA], (bf16*)RP(ka, R_ZS), (float*)RP(ka, R_VEC), (bf16*)RP(ka, R_ITG), unit, Rc, lds, tid); }
#endif
}
__device__ __forceinline__ void ph_hgrnB() {
    KA ka = fresh_args(); const int tid = fresh_tid();
    hgrn_scan((bf16*)RP(ka, R_ZS), (const float*)RP(ka, R_VEC), blockIdx.x * NTHREADS + tid, gridDim.x * NTHREADS);
}
__device__ __forceinline__ void ph_hgrnC(LAS unsigned char* lds, int b) {
#ifndef SKIP_HGRN
    KA ka = fresh_args(); const int tid = fresh_tid();
    const bf16* UB = (const bf16*)RP(ka, R_UB); const bf16* ITG = (const bf16*)RP(ka, R_ITG);
    HTiles R; if ((int)blockIdx.x < 4096) hgrn_load_c(R, UB, ITG, blockIdx.x, tid);
#pragma unroll 1
    for (int unit = blockIdx.x; unit < 4096; unit += gridDim.x) { const int nu = unit + gridDim.x;
        hgrn_passC(UB, ITG, (const bf16*)RP(ka, R_ZS), ka->in[I_GNW], (bf16*)WSP(ka, WS_HB) + (size_t)b * SEQ * DM, unit, nu < 4096 ? nu : -1, R, lds, tid); }
#endif
}

template <int PHX> __device__ __forceinline__ void ph_gemm_resid(LAS unsigned char* lds) {
    KA ka = fresh_args(); const int G = gridDim.x, bx = blockIdx.x;
    const bf16* A = (PHX == 6 || PHX == 19) ? (const bf16*)WSP(ka, WS_HB) : (const bf16*)RP(ka, R_ACT);
    const bf16* Bw = PHX == 6 ? (const bf16*)WSP(ka, WS_W_EVOUT) : PHX == 19 ? (const bf16*)WSP(ka, WS_W_ODOUT) : (const bf16*)WSP(ka, WS_W_DN) + (PHX == 22 ? (size_t)DM * FF : 0);
    const int K = (PHX == 6 || PHX == 19) ? DM : FF;
    const float* base = PHX == 6 ? ka->in[I_X] : ka->out;
    pg8::Gemm g{A, Bw, T, DM, K}; pg8::StaticOrder S; S.init(T, DM, G, bx); pg8::EpiResid E{base, ka->out, DM};
    pg8::gemm_phase<pg8::EpiResid, pg8::StaticOrder, true, true>(lds, g, S, E);
}
template <int LAYER> __device__ __forceinline__ void ph_gemm_gu(LAS unsigned char* lds) {
    KA ka = fresh_args(); const int G = gridDim.x, bx = blockIdx.x;
    pg8::Gemm g{(const bf16*)WSP(ka, WS_HB), (const bf16*)WSP(ka, WS_W_GU) + (LAYER ? (size_t)2 * FF * DM : 0), T, 2 * FF, DM}; pg8::StaticOrder S; S.init(T, 2 * FF, G, bx); pg8::EpiSwiglu E{(bf16*)RP(ka, R_ACT), FF};
    pg8::gemm_phase<pg8::EpiSwiglu, pg8::StaticOrder, true, true>(lds, g, S, E);
}
template <int BT> __device__ __forceinline__ void ph_gemm_odin(LAS unsigned char* lds) {
    KA ka = fresh_args(); const int G = gridDim.x, bx = blockIdx.x;
    pg8::Gemm g{(const bf16*)WSP(ka, WS_HB) + (BT ? (size_t)SEQ * DM : 0), (const bf16*)WSP(ka, WS_W_ODIN), SEQ, OD_N, DM}; pg8::StaticOrder S; S.init(SEQ, OD_N, G, bx); pg8::EpiStore E{(bf16*)RP(ka, R_UB), OD_N, 0};
    pg8::gemm_phase<pg8::EpiStore, pg8::StaticOrder, true, true>(lds, g, S, E);
}
__device__ __forceinline__ void ph_gemm_evin(LAS unsigned char* lds) {
    KA ka = fresh_args(); const int G = gridDim.x, bx = blockIdx.x;
    pg8::Gemm g{(const bf16*)WSP(ka, WS_HB), (const bf16*)WSP(ka, WS_W_EVIN), T, EV_N, DM}; pg8::StaticOrder S; S.init(T, EV_N, G, bx); pg8::EpiEvenIn E{(bf16*)RP(ka, R_HGLU), (bf16*)RP(ka, R_U2), U2_LD};
    pg8::gemm_phase<pg8::EpiEvenIn, pg8::StaticOrder, true, true>(lds, g, S, E);
}
__device__ __forceinline__ void ph_gemm_cmp(LAS unsigned char* lds) {
    KA ka = fresh_args(); const int G = gridDim.x, bx = blockIdx.x;
    pg8::Gemm g{(const bf16*)RP(ka, R_ACMP), (const bf16*)WSP(ka, WS_W_C1), 16384, 256, DM}; pg8::CmpOrder S{G, bx}; pg8::EpiCmpHid E{(bf16*)RP(ka, R_HID), (const float*)WSP(ka, WS_SMALL)};
    pg8::gemm_phase<pg8::EpiCmpHid, pg8::CmpOrder, true, true>(lds, g, S, E);
}

__global__ void __launch_bounds__(NTHREADS, 2) mega_fwd(Args args) {
    extern __shared__ __attribute__((aligned(16))) unsigned char lds_raw[];
    LAS unsigned char* lds = (LAS unsigned char*)lds_raw;
    const int lo = args.ph_lo, hi = args.ph_hi;
    if (threadIdx.x < 16) ((LAS unsigned*)(lds + BAR_LDS_OFF))[threadIdx.x] = 0u;
    __syncthreads();
    if (blockIdx.x == 0) for (int i = threadIdx.x; i < XCD_BAR_WORDS; i += NTHREADS) ((unsigned*)(fresh_args()->ws + WS_BAR))[i] = 0u;
#define PH(k, body) if (lo <= (k) && (k) < hi) { body; if ((k) + 1 < hi) { if ((k) == 0) cg::this_grid().sync(); else grid_barrier(lds); } }
    PH(0, ph_prologue(lds))
    (void)xcd_barrier_post((unsigned*)(fresh_args()->ws + WS_BAR), (volatile LAS unsigned*)(lds + BAR_LDS_OFF));
    PH(1, ph_gemm_evin(lds))
    PH(2, ph_conv(lds))
    PH(3, ph_gemm_cmp(lds))
    PH(4, ph_cmp2())
    PH(5, ph_nsa(lds))
    PH(6, ph_gemm_resid<6>(lds))
    PH(7, ph_norm(0))
    PH(8, ph_gemm_gu<0>(lds))
    PH(9, ph_gemm_resid<9>(lds))
    PH(10, ph_norm(1))
    PH(11, ph_gemm_odin<0>(lds))
    PH(12, ph_hgrnA(lds))
    PH(13, ph_hgrnB())
    PH(14, ph_hgrnC(lds, 0))
    PH(15, ph_gemm_odin<1>(lds))
    PH(16, ph_hgrnA(lds))
    PH(17, ph_hgrnB())
    PH(18, ph_hgrnC(lds, 1))
    PH(19, ph_gemm_resid<19>(lds))
    PH(20, ph_norm(2))
    PH(21, ph_gemm_gu<1>(lds))
    PH(22, ph_gemm_resid<22>(lds))
    PH(23, ph_norm(3))
}
constexpr int N_PHASES = 24;

extern "C" void kernel_launch(void* const* d_in, const int* in_sizes, int n_in, void* d_out, int out_size, void* d_ws, size_t ws_size, hipStream_t stream) {
    static int grid = 0;
    if (grid == 0) {
        if (n_in != 20 || out_size != T * DM || ws_size < WS_END) { fprintf(stderr, "kernel_launch: unexpected shapes (n_in %d out %d ws %zu need %zu)\n", n_in, out_size, ws_size, (size_t)WS_END); grid = -1; return; }
        int dev = 0, cus = 0, per_cu = 0;
        (void)hipGetDevice(&dev); (void)hipDeviceGetAttribute(&cus, hipDeviceAttributeMultiprocessorCount, dev);
        (void)hipFuncSetAttribute((const void*)mega_fwd, hipFuncAttributeMaxDynamicSharedMemorySize, LDS_BYTES);
        (void)hipOccupancyMaxActiveBlocksPerMultiprocessor(&per_cu, (const void*)mega_fwd, NTHREADS, LDS_BYTES);
        if (per_cu < 1) per_cu = 1;
        (void)hipGetLastError();
        grid = cus * per_cu;
    }
    if (grid < 0) return;
    Args a{};
    for (int i = 0; i < 20; ++i) a.in[i] = (const float*)d_in[i];
    a.out = (float*)d_out; a.ws = (unsigned char*)d_ws;
#ifndef MK_PER_PHASE
    a.ph_lo = 0; a.ph_hi = N_PHASES;
    void* kargs[] = {&a};
    hipError_t e = hipLaunchCooperativeKernel((const void*)mega_fwd, dim3(grid), dim3(NTHREADS), kargs, LDS_BYTES, stream);
    if (e != hipSuccess) fprintf(stderr, "cooperative launch failed: %s (grid %d)\n", hipGetErrorString(e), grid);
#else
    for (int p = 0; p < N_PHASES; ++p) { a.ph_lo = p; a.ph_hi = p + 1; hipLaunchKernelGGL(mega_fwd, dim3(grid), dim3(NTHREADS), LDS_BYTES, stream, a); }
#endif
}
```
